# Optimizing an MI355X kernel written in HIP

```python
import math
import jax
import jax.numpy as jnp
from jax import lax
import numpy as np

D_MODEL = 2048
BATCH = 2
SEQ = 8192
DEPTH = 1

GRID_W = 64
CTX_LEN = 256
HEAD_DIM = 128
ATTN_WIDTH = D_MODEL // 2
HYENA_WIDTH = D_MODEL - ATTN_WIDTH
MIX_WIDTH = ATTN_WIDTH + HYENA_WIDTH
N_Q_HEADS = ATTN_WIDTH // HEAD_DIM
N_KV_HEADS = 2
KV_GROUP = N_Q_HEADS // N_KV_HEADS
KV_WIDTH = N_KV_HEADS * HEAD_DIM
Q_END = ATTN_WIDTH
K_END = Q_END + KV_WIDTH
V_END = K_END + KV_WIDTH
IN_WIDTH = V_END + 3 * HYENA_WIDTH
Q_BLOCK = 128
ROPE_THETA = 10000.0
ROPE_AXIS_DIM = HEAD_DIM // 2
SHORT_CONV = 3
FILTER_EMB = 33
FILTER_BANDS = (FILTER_EMB - 1) // 2
FILTER_HIDDEN = 64
DECAY_TARGET = 1e-2
FAST_DECAY_PCT = 0.3
SLOW_DECAY_PCT = 1.5
MIN_DECAY = -math.log(DECAY_TARGET) / SLOW_DECAY_PCT
MAX_DECAY = -math.log(DECAY_TARGET) / FAST_DECAY_PCT
D_FF = 5632
N_MOD = 9
EPS = 1e-6
F32 = jnp.float32

kernel_name = "hymba_hyena_gqa_macaron_dit_layer"


def rms_norm(x, g):
    xf = x.astype(F32)
    y = xf * lax.rsqrt(jnp.mean(xf * xf, axis=-1, keepdims=True) + EPS)
    return (y * g.astype(F32)).astype(x.dtype)


def chunk(m, i):
    return m[..., i * D_MODEL:(i + 1) * D_MODEL]


def modulate(h, shift, scale):
    return h * (1 + scale) + shift


def swiglu(h, w_up, w_down):
    gate, up = jnp.split(h @ w_up, 2, axis=-1)
    return (jax.nn.silu(gate) * up) @ w_down


def half_ffn(s, m, slot, g, w_up, w_down):
    h = modulate(rms_norm(s, g), chunk(m, 3 * slot), chunk(m, 3 * slot + 1))
    return s + 0.5 * chunk(m, 3 * slot + 2) * swiglu(h, w_up, w_down)


def axial_rope_angles(L):
    rows = L // GRID_W
    row = jnp.repeat(jnp.arange(rows, dtype=jnp.int32), GRID_W)
    col = jnp.tile(jnp.arange(GRID_W, dtype=jnp.int32), rows)
    inv = ROPE_THETA ** (-jnp.arange(0, ROPE_AXIS_DIM, 2, dtype=F32) / ROPE_AXIS_DIM)
    ang = jnp.concatenate([row.astype(F32)[:, None] * inv, col.astype(F32)[:, None] * inv], axis=-1)
    return jnp.cos(ang), jnp.sin(ang)


def apply_rope(x, cos, sin):
    xf = x.astype(F32).reshape(*x.shape[:-1], HEAD_DIM // 2, 2)
    x0, x1 = xf[..., 0], xf[..., 1]
    c = cos[None, :, None, :]
    s = sin[None, :, None, :]
    out = jnp.stack([x0 * c - x1 * s, x0 * s + x1 * c], axis=-1)
    return out.reshape(x.shape).astype(x.dtype)


def q_heads(p_q, q_norm):
    B, L = p_q.shape[:2]
    return rms_norm(p_q.reshape(B, L, N_Q_HEADS, HEAD_DIM), q_norm)


def kv_heads(p_kv, k_norm):
    B, L = p_kv.shape[:2]
    k = rms_norm(p_kv[..., :KV_WIDTH].reshape(B, L, N_KV_HEADS, HEAD_DIM), k_norm)
    v = p_kv[..., KV_WIDTH:].reshape(B, L, N_KV_HEADS, HEAD_DIM)
    return k, v


def split_proj(p, q_norm, k_norm):
    q = q_heads(p[..., :Q_END], q_norm)
    k, v = kv_heads(p[..., Q_END:V_END], k_norm)
    return q, k, v, p[..., V_END:]


def block_attention(q, k, v):
    B, Lq = q.shape[:2]
    nblk = Lq // Q_BLOCK
    qb = q.reshape(B, nblk, Q_BLOCK, N_KV_HEADS, KV_GROUP, HEAD_DIM).transpose(1, 0, 2, 3, 4, 5)
    kf = k.astype(F32)
    vf = v.astype(F32)
    scale = HEAD_DIM ** -0.5

    def one_block(qblk):
        s = jnp.einsum('bqkgd,bskd->bkgqs', qblk.astype(F32), kf) * scale
        p = jax.nn.softmax(s, axis=-1)
        return jnp.einsum('bkgqs,bskd->bqkgd', p, vf).astype(q.dtype)

    ob = lax.map(one_block, qb)
    return ob.transpose(1, 0, 2, 3, 4, 5).reshape(B, Lq, N_Q_HEADS * HEAD_DIM)


def hyena_filters(L, w1, b1, w2, b2, w3, b3, w4, freq, decay):
    t = jnp.linspace(0.0, 1.0, L, dtype=F32)[:, None]
    w = 2.0 * math.pi * jnp.arange(L, dtype=F32)[:, None] / L
    f = jnp.linspace(1e-4, FILTER_BANDS - 1, FILTER_BANDS, dtype=F32)[None, :]
    z = jnp.concatenate([t, jnp.cos(f * w), -jnp.sin(f * w)], axis=-1)
    fr = freq.astype(F32)
    h = jnp.sin(fr * (z @ w1.astype(F32) + b1.astype(F32)))
    h = jnp.sin(fr * (h @ w2.astype(F32) + b2.astype(F32)))
    h = jnp.sin(fr * (h @ w3.astype(F32) + b3.astype(F32)))
    h = (h @ w4.astype(F32)).reshape(L, 2, HYENA_WIDTH)
    h = h * jnp.exp(-t[:, :, None] * jnp.abs(decay.astype(F32))[None])
    k_fwd, k_bwd = h[:, 0], h[:, 1]
    kk = jnp.concatenate([k_fwd, jnp.zeros((1, HYENA_WIDTH), F32), k_bwd[:0:-1]], axis=0)
    return kk / jnp.sum(jnp.abs(kk), axis=0, keepdims=True)


def long_conv(v, kk):
    L = v.shape[1]
    vf = jnp.fft.rfft(v.astype(F32), n=2 * L, axis=1)
    kf = jnp.fft.rfft(kk, n=2 * L, axis=0)
    return jnp.fft.irfft(vf * kf[None], n=2 * L, axis=1)[:, :L].astype(v.dtype)


def short_conv(u, w, b):
    L = u.shape[1]
    up = jnp.pad(u, ((0, 0), (1, 1), (0, 0)))
    return up[:, :L] * w[0] + up[:, 1:L + 1] * w[1] + up[:, 2:] * w[2] + b


def hyena_mixer(u, kk, conv_w, conv_b, hy_bias):
    uc = short_conv(u, conv_w, conv_b)
    x0, x1, v = jnp.split(uc, 3, axis=-1)
    v = v * x1
    v = long_conv(v, kk) + hy_bias * v
    return v * x0


def merge_groups(attn, hyo, g_out, w_out):
    y = jnp.concatenate([rms_norm(attn, g_out[:ATTN_WIDTH]), rms_norm(hyo, g_out[ATTN_WIDTH:])], axis=-1)
    return y @ w_out


def setup_inputs(seed: int = 0) -> dict:
    key = jax.random.key(seed)
    ks = jax.random.split(key, 32)

    def nrm(k, shape, fan_in, mult=1.0):
        return jax.random.normal(k, shape, F32) * (mult * fan_in ** -0.5)

    def gain(k, shape):
        return 1.0 + 0.05 * jax.random.normal(k, shape, F32)

    def small(k, shape):
        return 0.02 * jax.random.normal(k, shape, F32)

    return {
        "x": jax.random.normal(ks[0], (BATCH, SEQ, D_MODEL), F32),
        "c": jax.random.normal(ks[1], (BATCH, D_MODEL), F32),
        "ctx": jax.random.normal(ks[2], (BATCH, CTX_LEN, D_MODEL), F32),
        "c_ctx": jax.random.normal(ks[3], (D_MODEL,), F32),
        "w_ada": nrm(ks[4], (DEPTH, D_MODEL, N_MOD * D_MODEL), D_MODEL, 0.5),
        "b_ada": small(ks[5], (DEPTH, N_MOD * D_MODEL)),
        "g_norm": gain(ks[6], (DEPTH, 3, D_MODEL)),
        "w_ffn1_up": nrm(ks[7], (DEPTH, D_MODEL, 2 * D_FF), D_MODEL),
        "w_ffn1_down": nrm(ks[8], (DEPTH, D_FF, D_MODEL), D_FF),
        "w_ffn2_up": nrm(ks[9], (DEPTH, D_MODEL, 2 * D_FF), D_MODEL),
        "w_ffn2_down": nrm(ks[10], (DEPTH, D_FF, D_MODEL), D_FF),
        "w_in": nrm(ks[11], (DEPTH, D_MODEL, IN_WIDTH), D_MODEL),
        "q_norm": gain(ks[12], (DEPTH, HEAD_DIM)),
        "k_norm": gain(ks[13], (DEPTH, HEAD_DIM)),
        "conv_w": nrm(ks[14], (DEPTH, SHORT_CONV, 3 * HYENA_WIDTH), SHORT_CONV),
        "conv_b": small(ks[15], (DEPTH, 3 * HYENA_WIDTH)),
        "flt_w1": nrm(ks[16], (DEPTH, FILTER_EMB, FILTER_HIDDEN), FILTER_EMB, 2.0),
        "flt_b1": small(ks[17], (DEPTH, FILTER_HIDDEN)),
        "flt_w2": nrm(ks[18], (DEPTH, FILTER_HIDDEN, FILTER_HIDDEN), FILTER_HIDDEN, 2.0),
        "flt_b2": small(ks[19], (DEPTH, FILTER_HIDDEN)),
        "flt_w3": nrm(ks[20], (DEPTH, FILTER_HIDDEN, FILTER_HIDDEN), FILTER_HIDDEN, 2.0),
        "flt_b3": small(ks[21], (DEPTH, FILTER_HIDDEN)),
        "flt_w4": nrm(ks[22], (DEPTH, FILTER_HIDDEN, 2 * HYENA_WIDTH), FILTER_HIDDEN),
        "flt_freq": gain(ks[23], (DEPTH, FILTER_HIDDEN)),
        "flt_decay": jax.random.uniform(ks[24], (DEPTH, 2, HYENA_WIDTH), F32, MIN_DECAY, MAX_DECAY),
        "hy_bias": jax.random.normal(ks[25], (DEPTH, HYENA_WIDTH), F32),
        "g_out": gain(ks[26], (DEPTH, MIX_WIDTH)),
        "w_out": nrm(ks[27], (DEPTH, MIX_WIDTH, D_MODEL), MIX_WIDTH),
    }


def reference(x, c, ctx, c_ctx, w_ada, b_ada, g_norm, w_ffn1_up, w_ffn1_down, w_ffn2_up, w_ffn2_down,
              w_in, q_norm, k_norm, conv_w, conv_b, flt_w1, flt_b1, flt_w2, flt_b2, flt_w3, flt_b3,
              flt_w4, flt_freq, flt_decay, hy_bias, g_out, w_out):
    L = x.shape[1]
    Lc = ctx.shape[1]
    cos, sin = axial_rope_angles(L)
    s_lat = jax.nn.silu(c)
    s_ctx = jax.nn.silu(c_ctx)[None]
    for l in range(DEPTH):
        update_ctx = l < DEPTH - 1
        mod = (s_lat @ w_ada[l] + b_ada[l])[:, None, :]
        mod_c = (s_ctx @ w_ada[l] + b_ada[l])[:, None, :]
        flt = (flt_w1[l], flt_b1[l], flt_w2[l], flt_b2[l], flt_w3[l], flt_b3[l], flt_w4[l], flt_freq[l], flt_decay[l])

        x = half_ffn(x, mod, 0, g_norm[l, 0], w_ffn1_up[l], w_ffn1_down[l])
        ctx = half_ffn(ctx, mod_c, 0, g_norm[l, 0], w_ffn1_up[l], w_ffn1_down[l])

        h = modulate(rms_norm(x, g_norm[l, 1]), chunk(mod, 3), chunk(mod, 4))
        hc = modulate(rms_norm(ctx, g_norm[l, 1]), chunk(mod_c, 3), chunk(mod_c, 4))
        q, k, v, hy = split_proj(h @ w_in[l], q_norm[l], k_norm[l])
        if update_ctx:
            qc, kc, vc, hyc = split_proj(hc @ w_in[l], q_norm[l], k_norm[l])
        else:
            kc, vc = kv_heads(hc @ w_in[l, :, Q_END:V_END], k_norm[l])
        q = apply_rope(q, cos, sin)
        k = apply_rope(k, cos, sin)
        k_all = jnp.concatenate([kc, k], axis=1)
        v_all = jnp.concatenate([vc, v], axis=1)
        attn = block_attention(q, k_all, v_all)
        hyo = hyena_mixer(hy, hyena_filters(L, *flt), conv_w[l], conv_b[l], hy_bias[l])
        x = x + chunk(mod, 5) * merge_groups(attn, hyo, g_out[l], w_out[l])
        if update_ctx:
            attn_c = block_attention(qc, kc, vc)
            hyo_c = hyena_mixer(hyc, hyena_filters(Lc, *flt), conv_w[l], conv_b[l], hy_bias[l])
            ctx = ctx + chunk(mod_c, 5) * merge_groups(attn_c, hyo_c, g_out[l], w_out[l])
            ctx = half_ffn(ctx, mod_c, 2, g_norm[l, 2], w_ffn2_up[l], w_ffn2_down[l])

        x = half_ffn(x, mod, 2, g_norm[l, 2], w_ffn2_up[l], w_ffn2_down[l])
    return x
```

```cpp
#include <hip/hip_runtime.h>
#include <hip/hip_cooperative_groups.h>
#include <cstdio>
#include <cstdint>
namespace cg = cooperative_groups;

#define DUP_MASK 0
#ifndef ONE_LAUNCH
#define ONE_LAUNCH 1
#endif

#define LAS __attribute__((address_space(3)))
typedef unsigned short bf16_t;
typedef short bf16x8 __attribute__((ext_vector_type(8)));
typedef short s16x4 __attribute__((ext_vector_type(4)));
typedef float f32x2 __attribute__((ext_vector_type(2)));
typedef float f32x4 __attribute__((ext_vector_type(4)));
typedef float f32x16 __attribute__((ext_vector_type(16)));
typedef unsigned u32x2 __attribute__((ext_vector_type(2)));
typedef unsigned u32x4 __attribute__((ext_vector_type(4)));

constexpr int DM = 2048, NBATCH = 2, SEQ = 8192, CTXL = 256, HD = 128;
constexpr int MLAT = NBATCH * SEQ, MCTX = NBATCH * CTXL, MTOT = MLAT + MCTX;
constexpr int DFF = 5632, INW = 4608, NMODC = 9 * DM;
constexpr int HYW = 1024, ATW = 1024, NQH = 8, NKVH = 2;
constexpr int LKEYS = CTXL + SEQ;
constexpr int FFTN = 2 * SEQ;
constexpr float EPSN = 1e-6f;
constexpr int NTHR = 512;
constexpr int LDS_BYTES = 147456;

constexpr size_t MiB = 1u << 20;
constexpr size_t WS_MOD = 0, WS_PSUM = 1 * MiB;
constexpr size_t WS_W1U = 8 * MiB, WS_W1D = 52 * MiB, WS_WIN = 74 * MiB, WS_WOUT = 92 * MiB, WS_W2U = 100 * MiB, WS_W2D = 144 * MiB;
constexpr size_t WS_HA = 166 * MiB, WS_ACT = 232 * MiB, WS_X1 = 414 * MiB, WS_END = 546 * MiB;
constexpr size_t PART_OFF = (size_t)16 * MiB;
constexpr size_t WS_HF = WS_ACT;
constexpr size_t WS_P = WS_ACT;
constexpr size_t WS_Q = 8 * MiB, WS_K = 40 * MiB, WS_V = 49 * MiB;
constexpr size_t WS_VXT = WS_HA;
constexpr size_t WS_X0T = 381 * MiB;
constexpr size_t WS_HYOT = 232 * MiB;
constexpr size_t WS_ATTN = 296 * MiB;

struct Params { const float* in[28]; float* out; unsigned char* ws; int ph_lo, ph_hi; int dup_mask, pad; };

__device__ __forceinline__ unsigned cvt_pk_bf16(float lo, float hi) { unsigned r; asm volatile("v_cvt_pk_bf16_f32 %0, %1, %2" : "=v"(r) : "v"(lo), "v"(hi)); return r; }
__device__ __forceinline__ float bf_lo(unsigned w) { return __uint_as_float(w << 16); }
__device__ __forceinline__ float bf_hi(unsigned w) { return __uint_as_float(w & 0xffff0000u); }
__device__ __forceinline__ float bf2f(bf16_t b) { return __uint_as_float(((unsigned)b) << 16); }
__device__ __forceinline__ float wave_sum(float v) {
#pragma unroll
    for (int o = 1; o < 64; o <<= 1) v += __shfl_xor(v, o);
    return v;
}
#define LDS_WAIT() asm volatile("s_waitcnt lgkmcnt(0)" ::: "memory")
__device__ __forceinline__ int lane_id_asm() { int l; asm volatile("v_mbcnt_lo_u32_b32 %0, -1, 0\n\tv_mbcnt_hi_u32_b32 %0, -1, %0" : "=v"(l)); return l; }
#define TIDX(wv) (((wv) << 6) + lane_id_asm())

namespace pg8 {
constexpr int BM = 256, BK = 64, HALF = 128, HTB = HALF * BK * 2, STAGE_BYTES = 8 * HTB, NXCD = 8, WGM = 4;
__device__ __forceinline__ int lds_byte(int r, int c) { const int st = (r >> 4) * 2 + (c >> 5), rr = r & 15, cc = c & 31, ob = rr * 64 + cc * 2; return st * 1024 + (ob ^ (((ob >> 9) & 1) << 5)); }
__device__ __forceinline__ void stage_rc(int b, int& R, int& C) { const int st = b / 1024, sb = b % 1024, swz = sb ^ (((sb >> 9) & 1) << 5); R = (st >> 1) * 16 + swz / 64; C = (st & 1) * 32 + (swz % 64) / 2; }
__device__ __forceinline__ int perm32(int rho) { const int n = rho >> 4, i = rho & 15; return 8 * (i >> 2) + 4 * n + (i & 3); }
struct Unit { int pm, pn, k0; };
struct Gemm { const bf16_t* A; const bf16_t* Bt; int M, N, K, ldk; };
struct StaticOrder {
    int nM, nN, nwg, G, c;
    __device__ void init(int M, int N, int G_, int c_) { nM = M / BM; nN = N / BM; nwg = nM * nN; G = G_; c = c_; }
    __device__ bool next(int i, Unit& u) const {
        const long L = (long)i * G + c; if (L >= nwg) return false;
        int wgid = (int)L; { const int q = nwg / NXCD, r = nwg % NXCD, xcd = wgid % NXCD, off = wgid / NXCD; wgid = (xcd < r ? xcd * (q + 1) : r * (q + 1) + (xcd - r) * q) + off; }
        const int nig = WGM * nN, gid = wgid / nig, fm = gid * WGM, gsz = (nM - fm) < WGM ? (nM - fm) : WGM;
        u.pm = fm + ((wgid % nig) % gsz); u.pn = (wgid % nig) / gsz; u.k0 = 0; return true;
    }
};

constexpr int NSPLIT = 11, KSPLIT = DFF / NSPLIT;
struct SplitOrder {
    int G, c;
    __device__ void init(int G_, int c_) { G = G_; c = c_; }
    __device__ bool next(int i, Unit& u) const {
        const int L = i * G + c; if (L >= 16 * NSPLIT) return false;
        const int ks = L % NSPLIT, tl = L / NSPLIT;
        u.k0 = ks * KSPLIT; u.pn = tl & 7; u.pm = 64 + (tl >> 3); return true;
    }
};
struct EpiBf16 {
    static constexpr bool PERM = true;
    bf16_t* O; int ldc;
    __device__ __forceinline__ void operator()(const f32x4 (&acc)[2][2][4][2], const Unit& u, int wr, int wc, int fr, int fq) const {
        const int row0 = u.pm * BM + wr * 64 + fr, col0 = u.pn * BM + wc * 32 + 8 * fq;
#pragma unroll
        for (int ai = 0; ai < 2; ++ai)
#pragma unroll
            for (int m = 0; m < 4; ++m) { bf16_t* rowp = O + (size_t)(row0 + ai * HALF + m * 16) * ldc + col0;
#pragma unroll
                for (int bj = 0; bj < 2; ++bj) { const f32x4 v0 = acc[ai][bj][m][0], v1 = acc[ai][bj][m][1];
                    u32x4 w; w.x = cvt_pk_bf16(v0[0], v0[1]); w.y = cvt_pk_bf16(v0[2], v0[3]); w.z = cvt_pk_bf16(v1[0], v1[1]); w.w = cvt_pk_bf16(v1[2], v1[3]);
                    *(u32x4*)(rowp + bj * HALF) = w; } }
    }
};
__device__ __forceinline__ float silu_mul(float g, float u) { return g * u * __builtin_amdgcn_rcpf(1.0f + __builtin_amdgcn_exp2f(-1.4426950408889634f * g)); }
struct EpiSwiglu {
    static constexpr bool PERM = true;
    bf16_t* O; int ldc;
    __device__ __forceinline__ void operator()(const f32x4 (&acc)[2][2][4][2], const Unit& u, int wr, int wc, int fr, int fq) const {
        const int row0 = u.pm * BM + wr * 64 + fr, col0 = u.pn * HALF + wc * 32 + 8 * fq;
#pragma unroll
        for (int ai = 0; ai < 2; ++ai)
#pragma unroll
            for (int m = 0; m < 4; ++m) { bf16_t* rowp = O + (size_t)(row0 + ai * HALF + m * 16) * ldc + col0;
                const f32x4 g0 = acc[ai][0][m][0], g1 = acc[ai][0][m][1], u0 = acc[ai][1][m][0], u1 = acc[ai][1][m][1];
                u32x4 w;
                w.x = cvt_pk_bf16(silu_mul(g0[0], u0[0]), silu_mul(g0[1], u0[1])); w.y = cvt_pk_bf16(silu_mul(g0[2], u0[2]), silu_mul(g0[3], u0[3]));
                w.z = cvt_pk_bf16(silu_mul(g1[0], u1[0]), silu_mul(g1[1], u1[1])); w.w = cvt_pk_bf16(silu_mul(g1[2], u1[2]), silu_mul(g1[3], u1[3]));
                *(u32x4*)rowp = w; }
    }
};
struct EpiResid {
    static constexpr bool PERM = false;
    const float* base_lat; const float* base_ctx; float* out; const float* gate0; float gscale;
    __device__ __forceinline__ void operator()(const f32x4 (&acc)[2][2][4][2], const Unit& u, int wr, int wc, int fr, int fq) const {
        const int mi = u.pm < 32 ? 0 : (u.pm < 64 ? 1 : 2);
        const float* gate = gate0 + (size_t)mi * NMODC;
        const int row0 = u.pm * BM + wr * 64 + fr, col0 = u.pn * BM + wc * 32 + 4 * fq;
        f32x4 gv[2][2];
#pragma unroll
        for (int bj = 0; bj < 2; ++bj)
#pragma unroll
            for (int n = 0; n < 2; ++n) gv[bj][n] = *(const f32x4*)(gate + col0 + bj * HALF + n * 16) * gscale;
#pragma unroll
        for (int ai = 0; ai < 2; ++ai)
#pragma unroll
            for (int m = 0; m < 4; ++m) { const size_t off = (size_t)(row0 + ai * HALF + m * 16) * DM + col0;
                const float* bp = (u.pm < 64) ? (base_lat + off) : (base_ctx + (off - (size_t)MLAT * DM));
#pragma unroll
                for (int bj = 0; bj < 2; ++bj)
#pragma unroll
                    for (int n = 0; n < 2; ++n) { const f32x4 bs = *(const f32x4*)(bp + bj * HALF + n * 16);
                        *(f32x4*)(out + off + bj * HALF + n * 16) = bs + gv[bj][n] * acc[ai][bj][m][n]; }
                if (m == 3) asm volatile("" ::: "memory"); }
    }
};

struct EpiPartial {
    static constexpr bool PERM = false;
    float* part;
    __device__ __forceinline__ void operator()(const f32x4 (&acc)[2][2][4][2], const Unit& u, int wr, int wc, int fr, int fq) const {
        const int ks = u.k0 / KSPLIT;
        float* base = part + (size_t)ks * MCTX * DM;
        const int row0 = (u.pm - 64) * BM + wr * 64 + fr, col0 = u.pn * BM + wc * 32 + 4 * fq;
#pragma unroll
        for (int ai = 0; ai < 2; ++ai)
#pragma unroll
            for (int m = 0; m < 4; ++m) { float* rp = base + (size_t)(row0 + ai * HALF + m * 16) * DM + col0;
#pragma unroll
                for (int bj = 0; bj < 2; ++bj)
#pragma unroll
                    for (int n = 0; n < 2; ++n) *(f32x4*)(rp + bj * HALF + n * 16) = acc[ai][bj][m][n]; }
    }
};

template <class Epi, class Sched, bool ALIGN_EPI = true, bool SP2 = true>
__device__ __forceinline__ void gemm_phase(LAS unsigned char* lds, const Gemm g, const Sched& S, const Epi& E, int wv) {
    const int tid = TIDX(wv), wid = wv, lane = tid & 63, wr = wid >> 2, wc = wid & 3, fr = lane & 15, fq = lane >> 4;
    const int K = g.ldk, nt = g.K / BK;
    unsigned voffA[2], voffB[2];
#pragma unroll
    for (int i = 0; i < 2; ++i) { int R, C; stage_rc(tid * 16 + i * 8192, R, C); const int Rb = Epi::PERM ? ((R & ~31) + perm32(R & 31)) : R;
        voffA[i] = (unsigned)(R * K + C) * 2u; voffB[i] = (unsigned)(Rb * K + C) * 2u; }
    const size_t kstep = (size_t)(BK * 2);
    const size_t hstep = (size_t)HALF * K * 2;
    const size_t tstep = 2 * hstep;
    const unsigned ldsw = (unsigned)wid * 1024u;
    const int aoff = lds_byte(wr * 64 + fr, fq * 8), boff = lds_byte(wc * 32 + fr, fq * 8);
#define PG8_SA(b, h) (((b) * 2 + (h)) * HTB)
#define PG8_SB(b, h) ((4 + (b) * 2 + (h)) * HTB)
#define PG8_STAGE(bufoff, gbase, voff) do { _Pragma("unroll") for (int _i = 0; _i < 2; ++_i) \
        __builtin_amdgcn_global_load_lds((const unsigned*)((const char*)(gbase) + (voff)[_i]), (LAS unsigned*)(lds + (bufoff) + ldsw + _i * 8192), 16, 0, 0); } while (0)
#define PG8_LDA(dst, b, h) do { _Pragma("unroll") for (int m = 0; m < 4; ++m) _Pragma("unroll") for (int k = 0; k < 2; ++k) dst[m][k] = *(const LAS bf16x8*)(lds + PG8_SA(b, h) + aoff + m * 2048 + k * 1024); } while (0)
#define PG8_LDB(dst, b, h) do { _Pragma("unroll") for (int n = 0; n < 2; ++n) _Pragma("unroll") for (int k = 0; k < 2; ++k) dst[n][k] = *(const LAS bf16x8*)(lds + PG8_SB(b, h) + boff + n * 2048 + k * 1024); } while (0)
#define PG8_MMA(ai, bj, At, Bt) do { __builtin_amdgcn_s_setprio(1); _Pragma("unroll") for (int m = 0; m < 4; ++m) _Pragma("unroll") for (int n = 0; n < 2; ++n) _Pragma("unroll") for (int k = 0; k < 2; ++k) \
        acc[ai][bj][m][n] = __builtin_amdgcn_mfma_f32_16x16x32_bf16(Bt[n][k], At[m][k], acc[ai][bj][m][n], 0, 0, 0); __builtin_amdgcn_s_setprio(0); } while (0)
#define PG8_WAIT_V(n) asm volatile("s_waitcnt vmcnt(" #n ")" ::: "memory")
#define PG8_WAIT_L(n) asm volatile("s_waitcnt lgkmcnt(" #n ")" ::: "memory")
#define PG8_BAR __builtin_amdgcn_s_barrier()
#define PG8_SCHED __builtin_amdgcn_sched_barrier(0)
    Unit cur, nxt; int ui = 0;
    if (!S.next(0, cur)) return;
    f32x4 acc[2][2][4][2];
#pragma unroll
    for (int a = 0; a < 2; ++a)
#pragma unroll
        for (int b = 0; b < 2; ++b)
#pragma unroll
            for (int m = 0; m < 4; ++m)
#pragma unroll
                for (int n = 0; n < 2; ++n) acc[a][b][m][n] = (f32x4){0.f, 0.f, 0.f, 0.f};
    bf16x8 At[4][2], B0[2][2], B1[2][2];
    const char* cA = (const char*)g.A + (size_t)cur.pm * tstep + (size_t)cur.k0 * 2; const char* cB = (const char*)g.Bt + (size_t)cur.pn * tstep + (size_t)cur.k0 * 2;
    if constexpr (SP2) {
        PG8_STAGE(PG8_SB(0, 0), cB, voffB); PG8_STAGE(PG8_SB(0, 1), cB + hstep, voffB); PG8_STAGE(PG8_SA(0, 0), cA, voffA); PG8_STAGE(PG8_SA(0, 1), cA + hstep, voffA);
        if (wr == 1) PG8_BAR;
        PG8_WAIT_V(2); PG8_BAR;
        PG8_STAGE(PG8_SB(1, 0), cB + kstep, voffB); PG8_STAGE(PG8_SA(1, 0), cA + kstep, voffA); PG8_STAGE(PG8_SB(1, 1), cB + hstep + kstep, voffB);
        PG8_WAIT_V(6); PG8_BAR;
    } else {
        PG8_STAGE(PG8_SB(0, 0), cB, voffB); PG8_STAGE(PG8_SA(0, 0), cA, voffA); PG8_STAGE(PG8_SB(0, 1), cB + hstep, voffB); PG8_STAGE(PG8_SA(0, 1), cA + hstep, voffA);
        if (wr == 1) PG8_BAR;
        PG8_WAIT_V(4); PG8_BAR;
        PG8_STAGE(PG8_SB(1, 0), cB + kstep, voffB); PG8_STAGE(PG8_SA(1, 0), cA + kstep, voffA); PG8_STAGE(PG8_SB(1, 1), cB + hstep + kstep, voffB);
        PG8_WAIT_V(6); PG8_BAR;
    }
    for (;;) {
        const bool has_next = S.next(ui + 1, nxt);
        const char* nA = has_next ? (const char*)g.A + (size_t)nxt.pm * tstep + (size_t)nxt.k0 * 2 : cA; const char* nB = has_next ? (const char*)g.Bt + (size_t)nxt.pn * tstep + (size_t)nxt.k0 * 2 : cB;
        for (int t = 0; t < nt; t += 2) {
            const bool last = (t == nt - 2);
            const char* a1 = cA + (size_t)(t + 1) * kstep;
            const char* a2 = last ? nA : cA + (size_t)(t + 2) * kstep; const char* b2 = last ? nB : cB + (size_t)(t + 2) * kstep;
            const char* a3 = a2 + kstep; const char* b3 = b2 + kstep;
            if constexpr (SP2) {
            PG8_LDB(B0, 0, 0); PG8_LDB(B1, 0, 1); PG8_SCHED; PG8_LDA(At, 0, 0); PG8_STAGE(PG8_SA(1, 1), a1 + hstep, voffA);
            PG8_WAIT_V(8); PG8_WAIT_L(0); PG8_BAR; PG8_MMA(0, 0, At, B0); PG8_MMA(0, 1, At, B1); PG8_BAR; PG8_SCHED;
            PG8_LDA(At, 0, 1); PG8_STAGE(PG8_SB(0, 0), b2, voffB); PG8_STAGE(PG8_SB(0, 1), b2 + hstep, voffB); PG8_STAGE(PG8_SA(0, 0), a2, voffA);
            PG8_WAIT_V(8); PG8_WAIT_L(0); PG8_BAR; PG8_MMA(1, 0, At, B0); PG8_MMA(1, 1, At, B1); PG8_BAR; PG8_SCHED;
            PG8_LDB(B0, 1, 0); PG8_LDB(B1, 1, 1); PG8_SCHED; PG8_LDA(At, 1, 0); PG8_STAGE(PG8_SA(0, 1), a2 + hstep, voffA);
            PG8_WAIT_V(8); PG8_WAIT_L(0); PG8_BAR; PG8_MMA(0, 0, At, B0); PG8_MMA(0, 1, At, B1); PG8_BAR; PG8_SCHED;
            PG8_LDA(At, 1, 1); PG8_STAGE(PG8_SB(1, 0), b3, voffB); PG8_STAGE(PG8_SB(1, 1), b3 + hstep, voffB); PG8_STAGE(PG8_SA(1, 0), a3, voffA);
            PG8_WAIT_V(8); PG8_WAIT_L(0); PG8_BAR; PG8_MMA(1, 0, At, B0); PG8_MMA(1, 1, At, B1); PG8_BAR; PG8_SCHED;
            } else {
            PG8_LDB(B0, 0, 0); PG8_SCHED; PG8_LDA(At, 0, 0); PG8_STAGE(PG8_SA(1, 1), a1 + hstep, voffA);
            PG8_WAIT_L(8); PG8_BAR; PG8_WAIT_L(0); PG8_MMA(0, 0, At, B0); PG8_BAR; PG8_SCHED;
            PG8_LDB(B1, 0, 1); PG8_STAGE(PG8_SB(0, 0), b2, voffB);
            PG8_BAR; PG8_WAIT_L(0); PG8_MMA(0, 1, At, B1); PG8_BAR;
            PG8_LDA(At, 0, 1); PG8_STAGE(PG8_SA(0, 0), a2, voffA);
            PG8_BAR; PG8_WAIT_L(0); PG8_MMA(1, 0, At, B0); PG8_BAR; PG8_SCHED;
            PG8_STAGE(PG8_SB(0, 1), b2 + hstep, voffB);
            PG8_WAIT_V(6); PG8_BAR; PG8_MMA(1, 1, At, B1); PG8_BAR;
            PG8_LDB(B0, 1, 0); PG8_SCHED; PG8_LDA(At, 1, 0); PG8_STAGE(PG8_SA(0, 1), a2 + hstep, voffA);
            PG8_WAIT_L(8); PG8_BAR; PG8_WAIT_L(0); PG8_MMA(0, 0, At, B0); PG8_BAR; PG8_SCHED;
            PG8_LDB(B1, 1, 1); PG8_STAGE(PG8_SB(1, 0), b3, voffB);
            PG8_BAR; PG8_WAIT_L(0); PG8_MMA(0, 1, At, B1); PG8_BAR;
            PG8_LDA(At, 1, 1); PG8_STAGE(PG8_SA(1, 0), a3, voffA);
            PG8_BAR; PG8_WAIT_L(0); PG8_MMA(1, 0, At, B0); PG8_BAR; PG8_SCHED;
            PG8_STAGE(PG8_SB(1, 1), b3 + hstep, voffB);
            PG8_WAIT_V(6); PG8_BAR; PG8_MMA(1, 1, At, B1); PG8_BAR;
            }
        }
        if constexpr (ALIGN_EPI) { if (wr == 0) PG8_BAR; }
        E(acc, cur, wr, wc, fr, fq);
        if (!has_next) break;
#pragma unroll
        for (int a = 0; a < 2; ++a)
#pragma unroll
            for (int b = 0; b < 2; ++b)
#pragma unroll
                for (int m = 0; m < 4; ++m)
#pragma unroll
                    for (int n = 0; n < 2; ++n) acc[a][b][m][n] = (f32x4){0.f, 0.f, 0.f, 0.f};
        cur = nxt; cA = nA; cB = nB; ++ui;
        if constexpr (ALIGN_EPI) { if (wr == 1) PG8_BAR; }
    }
    PG8_WAIT_V(0);
    if constexpr (!ALIGN_EPI) { if (wr == 0) PG8_BAR; }
    PG8_BAR;
#undef PG8_SA
#undef PG8_SB
#undef PG8_STAGE
#undef PG8_LDA
#undef PG8_LDB
#undef PG8_MMA
#undef PG8_WAIT_V
#undef PG8_WAIT_L
#undef PG8_BAR
#undef PG8_SCHED
}
}

namespace att {
constexpr int D = 128, NW = 8, QBLK = 32, KVBLK = 64;
constexpr float SCALE = 0.088388347648318440f;
constexpr float THR = 8.f;
#ifndef ATT_SDEPTH
#define ATT_SDEPTH 1
#endif
constexpr int LDQ = 128, LDK = 128, LDO = ATW;
constexpr size_t SHM_V = KVBLK * D * 2, SHM_K = KVBLK * D * 2, SHM_ATTN = 2 * SHM_V + 2 * SHM_K + NW * 64 * 4;
#define KSWZ(row, colB) ((row) * 256 + ((colB) ^ (((row) & 7) << 4)))
#define SBAR() __builtin_amdgcn_sched_barrier(0)
__device__ __forceinline__ int crow(int r, int hi) { return (r & 3) + 8 * (r >> 2) + 4 * hi; }
__device__ __forceinline__ unsigned cvtpk(float lo, float hi) { unsigned r; asm volatile("v_cvt_pk_bf16_f32 %0, %1, %2" : "=v"(r) : "v"(lo), "v"(hi)); return r; }
__device__ __forceinline__ void partialSM(f32x16& p0, f32x16& p1, float& m_reg, float& mn, float& alpha) {
  constexpr float C = SCALE * 1.4426950408889634f;
  float pmax = p0[0]; for (int r = 1; r < 16; ++r) pmax = fmaxf(pmax, p0[r]); for (int r = 0; r < 16; ++r) pmax = fmaxf(pmax, p1[r]);
  { auto rr = __builtin_amdgcn_permlane32_swap(__float_as_uint(pmax), __float_as_uint(pmax), false, false);
    pmax = fmaxf(__uint_as_float(rr[0]), __uint_as_float(rr[1])); }
  if (__builtin_expect(__all(pmax - m_reg <= THR / SCALE), 1)) { mn = m_reg; alpha = 1.f; }
  else { mn = fmaxf(m_reg, pmax); alpha = __builtin_amdgcn_exp2f((m_reg - mn) * C); m_reg = mn; }
  float mnC = -mn * C;
  for (int r = 0; r < 16; ++r) p0[r] = fmaf(p0[r], C, mnC); for (int r = 0; r < 16; ++r) p1[r] = fmaf(p1[r], C, mnC);
  for (int r = 0; r < 16; ++r) p0[r] = __builtin_amdgcn_exp2f(p0[r]);
}
__device__ __forceinline__ void finishSM(f32x16& p0, f32x16& p1, float alpha, float& l_reg, bf16x8& pa0, bf16x8& pa1, bf16x8& pa2, bf16x8& pa3) {
  for (int r = 0; r < 16; ++r) p1[r] = __builtin_amdgcn_exp2f(p1[r]);
  float ps = 0; for (int r = 0; r < 16; ++r) ps += p0[r]; for (int r = 0; r < 16; ++r) ps += p1[r];
  { auto rr = __builtin_amdgcn_permlane32_swap(__float_as_uint(ps), __float_as_uint(ps), false, false);
    ps = __uint_as_float(rr[0]) + __uint_as_float(rr[1]); }
  l_reg = l_reg * alpha + ps;
#define PK4(P, BASE, OUT) do { unsigned a0 = cvtpk(P[BASE + 0], P[BASE + 1]), a1 = cvtpk(P[BASE + 2], P[BASE + 3]);   \
    unsigned b0 = cvtpk(P[BASE + 4], P[BASE + 5]), b1 = cvtpk(P[BASE + 6], P[BASE + 7]);                              \
    auto r0 = __builtin_amdgcn_permlane32_swap(a0, b0, false, false); auto r1 = __builtin_amdgcn_permlane32_swap(a1, b1, false, false); \
    u32x4 w = {r0[0], r1[0], r0[1], r1[1]}; OUT = *reinterpret_cast<bf16x8*>(&w); } while (0)
  PK4(p0, 0, pa0); PK4(p0, 8, pa1); PK4(p1, 0, pa2); PK4(p1, 8, pa3);
#undef PK4
}
__device__ __forceinline__ void qkt(f32x16& p0, f32x16& p1, const bf16_t* Ks, const bf16x8* qr, int r32, int hi) {
  p0 = f32x16{}; p1 = f32x16{};
  for (int d0 = 0; d0 < 8; ++d0) { int cb = (d0 * 16 + hi * 8) * 2;
    bf16x8 b0 = *reinterpret_cast<const bf16x8*>((const char*)Ks + KSWZ(r32, cb));
    bf16x8 b1 = *reinterpret_cast<const bf16x8*>((const char*)Ks + KSWZ(32 + r32, cb));
    p0 = __builtin_amdgcn_mfma_f32_32x32x16_bf16(b0, qr[d0], p0, 0, 0, 0);
    p1 = __builtin_amdgcn_mfma_f32_32x32x16_bf16(b1, qr[d0], p1, 0, 0, 0); }
}
__device__ __forceinline__ int v_st(int k, int c) { const int kk = (k & ~0xC) | ((k & 4) << 1) | ((k & 8) >> 1); return ((kk >> 3) * 4 + (c >> 5)) * 512 + ((kk & 7) * 32 + (c & 31)) * 2; }
__device__ __forceinline__ int v_rd_base(int lane) { return ((lane & 3) << 3) | (((lane >> 2) & 3) << 6) | (((lane >> 4) & 1) << 5) | (((lane >> 5) & 1) << 8); }
constexpr int v_rd_off(int d0, int ks, int half) { return d0 * 512 + ks * 4096 + half * 2048; }
template <int OFF> __device__ __forceinline__ s16x4 tr_read(int vb) {
  s16x4 r; asm volatile("ds_read_b64_tr_b16 %0, %1 offset:%2" : "=&v"(r) : "v"(vb), "i"(OFF) : "memory"); return r;
}
template <int D0> __device__ __forceinline__ void pv_one(f32x16& od, int vb, bf16x8 pa0, bf16x8 pa1, bf16x8 pa2, bf16x8 pa3) {
  const s16x4 l0 = tr_read<v_rd_off(D0, 0, 0)>(vb), h0 = tr_read<v_rd_off(D0, 0, 1)>(vb), l1 = tr_read<v_rd_off(D0, 1, 0)>(vb), h1 = tr_read<v_rd_off(D0, 1, 1)>(vb);
  const s16x4 l2 = tr_read<v_rd_off(D0, 2, 0)>(vb), h2 = tr_read<v_rd_off(D0, 2, 1)>(vb), l3 = tr_read<v_rd_off(D0, 3, 0)>(vb), h3 = tr_read<v_rd_off(D0, 3, 1)>(vb);
  asm volatile("s_waitcnt lgkmcnt(0)" ::: "memory"); SBAR();
#define PK(L, H) (bf16x8){L[0], L[1], L[2], L[3], H[0], H[1], H[2], H[3]}
  od = __builtin_amdgcn_mfma_f32_32x32x16_bf16(pa0, PK(l0, h0), od, 0, 0, 0);
  od = __builtin_amdgcn_mfma_f32_32x32x16_bf16(pa1, PK(l1, h1), od, 0, 0, 0);
  od = __builtin_amdgcn_mfma_f32_32x32x16_bf16(pa2, PK(l2, h2), od, 0, 0, 0);
  od = __builtin_amdgcn_mfma_f32_32x32x16_bf16(pa3, PK(l3, h3), od, 0, 0, 0);
#undef PK
}
__device__ __forceinline__ void pv_d0(f32x16* o, int vb, bf16x8 pa0, bf16x8 pa1, bf16x8 pa2, bf16x8 pa3) {
  pv_one<0>(o[0], vb, pa0, pa1, pa2, pa3); pv_one<1>(o[1], vb, pa0, pa1, pa2, pa3); pv_one<2>(o[2], vb, pa0, pa1, pa2, pa3); pv_one<3>(o[3], vb, pa0, pa1, pa2, pa3);
}
__device__ __forceinline__ void attn_dense_body(const bf16_t* __restrict__ Qb, const bf16_t* __restrict__ Kh, const bf16_t* __restrict__ Vh,
                                                float* __restrict__ Ob, int seq, char* lds, int wv) {
  const int tid = TIDX(wv), wid = tid >> 6, lane = tid & 63, r32 = lane & 31, hi = lane >> 5;
  bf16_t* V_lds = (bf16_t*)lds; bf16_t* K_lds = (bf16_t*)(lds + 2 * SHM_V);
  float* ws = (float*)(lds + 2 * SHM_V + 2 * SHM_K) + wid * 64; float* li_l = ws; float* al_l = ws + 32;
  float m_reg = -1e30f, l_reg = 0; f32x16 o[4] = {}; bf16x8 qr[8];
  const bf16_t* Qw = Qb + (long)(wid * QBLK + r32) * LDQ + hi * 8;
#pragma unroll
  for (int d0 = 0; d0 < 8; ++d0) qr[d0] = *reinterpret_cast<const bf16x8*>(Qw + d0 * 16);
  const int sr = tid >> 4, sc = (tid & 15) * 8, vst0 = v_st(sr, sc), vst1 = v_st(32 + sr, sc);
  const int vb0 = (int)(uintptr_t)V_lds + v_rd_base(lane);
  constexpr int SDEPTH = ATT_SDEPTH;
  struct { bf16x8 vs0, vs1, ks0, ks1; } sr_[SDEPTH];
#define SLOAD(i, k0) do { sr_[i].vs0 = *reinterpret_cast<const bf16x8*>(&Vh[(long)((k0) + sr) * LDK + sc]); sr_[i].vs1 = *reinterpret_cast<const bf16x8*>(&Vh[(long)((k0) + 32 + sr) * LDK + sc]); \
    sr_[i].ks0 = *reinterpret_cast<const bf16x8*>(&Kh[(long)((k0) + sr) * LDK + sc]); sr_[i].ks1 = *reinterpret_cast<const bf16x8*>(&Kh[(long)((k0) + 32 + sr) * LDK + sc]); } while (0)
#define SWRITE(b, i) do { *(bf16x8*)((char*)V_lds + (b) * SHM_V + vst0) = sr_[i].vs0;          \
    *(bf16x8*)((char*)V_lds + (b) * SHM_V + vst1) = sr_[i].vs1; int kc = sc * 2;               \
    *(bf16x8*)((char*)K_lds + (b) * SHM_K + KSWZ(sr, kc)) = sr_[i].ks0;                       \
    *(bf16x8*)((char*)K_lds + (b) * SHM_K + KSWZ(32 + sr, kc)) = sr_[i].ks1; } while (0)
#define SWAIT() do { if (SDEPTH == 2) asm volatile("s_waitcnt vmcnt(4)" ::: "memory"); else asm volatile("s_waitcnt vmcnt(0)" ::: "memory"); } while (0)
#define RESC(a) do { if (__any((a) < 1.f)) { if (hi == 0) al_l[r32] = (a); asm volatile("s_waitcnt lgkmcnt(0)" ::: "memory"); \
    for (int d = 0; d < 4; ++d) for (int r = 0; r < 16; ++r) o[d][r] *= al_l[crow(r, hi)]; } } while (0)
  f32x16 pA0, pA1, pB0, pB1; float mnA, mnB, alA, alB; bf16x8 pa0, pa1, pa2, pa3; const int NT = seq / KVBLK;
  constexpr int SE = 0, SO = SDEPTH - 1;
  SLOAD(SE, 0); asm volatile("s_waitcnt vmcnt(0)" ::: "memory"); SWRITE(0, SE); __syncthreads();
  qkt(pA0, pA1, K_lds, qr, r32, hi); partialSM(pA0, pA1, m_reg, mnA, alA);
  SLOAD(SO, KVBLK); if (SDEPTH == 2) { if (2 < NT) SLOAD(SE, 2 * KVBLK); }
  SWAIT(); SWRITE(1, SO); __syncthreads();
  for (int j = 1; j + 1 < NT; j += 2) {
    SBAR(); qkt(pB0, pB1, (bf16_t*)((char*)K_lds + SHM_K), qr, r32, hi);
    finishSM(pA0, pA1, alA, l_reg, pa0, pa1, pa2, pa3); SBAR();
    SLOAD(SO, (j + SDEPTH) * KVBLK); SBAR();
    pv_d0(o, vb0, pa0, pa1, pa2, pa3); partialSM(pB0, pB1, m_reg, mnB, alB);
    __syncthreads(); SWAIT(); SWRITE(0, SE);
    RESC(alB); __syncthreads();
    SBAR(); qkt(pA0, pA1, K_lds, qr, r32, hi);
    finishSM(pB0, pB1, alB, l_reg, pa0, pa1, pa2, pa3); SBAR();
    if (SDEPTH == 1 || j + 3 < NT) SLOAD(SE, (j + 1 + SDEPTH) * KVBLK); SBAR();
    pv_d0(o, vb0 + (int)SHM_V, pa0, pa1, pa2, pa3); partialSM(pA0, pA1, m_reg, mnA, alA);
    __syncthreads(); SWAIT(); SWRITE(1, SO);
    RESC(alA); __syncthreads();
  }
  SBAR(); qkt(pB0, pB1, (bf16_t*)((char*)K_lds + SHM_K), qr, r32, hi);
  finishSM(pA0, pA1, alA, l_reg, pa0, pa1, pa2, pa3); SBAR();
  pv_d0(o, vb0, pa0, pa1, pa2, pa3); partialSM(pB0, pB1, m_reg, mnB, alB);
  __syncthreads(); RESC(alB);
  finishSM(pB0, pB1, alB, l_reg, pa0, pa1, pa2, pa3); SBAR();
  pv_d0(o, vb0 + (int)SHM_V, pa0, pa1, pa2, pa3);
  if (hi == 0) li_l[r32] = l_reg; asm volatile("s_waitcnt lgkmcnt(0)" ::: "memory");
  float rli[16];
#pragma unroll
  for (int r = 0; r < 16; ++r) rli[r] = __builtin_amdgcn_rcpf(li_l[crow(r, hi)]);
  float* Ow = Ob + (long)(wid * QBLK) * LDO;
#pragma unroll
  for (int r = 0; r < 16; ++r) { int orow = crow(r, hi);
    for (int d0 = 0; d0 < 4; ++d0) Ow[(long)orow * LDO + d0 * 32 + r32] = o[d0][r] * rli[r]; }
#undef SLOAD
#undef SWRITE
#undef SWAIT
#undef RESC
}
}

struct TrItem { const float* W; bf16_t* WT; int K, N, k0, n0, drow0; };
__device__ __forceinline__ int up_row(int n0) { const int half = n0 / DFF, rem = n0 - half * DFF; return 256 * (rem >> 7) + 128 * half + (rem & 127); }
__device__ __forceinline__ TrItem tr_decode(const Params& p, int it) {
    constexpr int I_U = (DM / 64) * (2 * DFF / 64), I_D = (DFF / 64) * (DM / 64), I_IN = (DM / 64) * (INW / 64), I_O = (DM / 64) * (DM / 64);
    unsigned char* ws = p.ws; TrItem t; int r = it; int nblk; bool up = false;
    if (r < I_U) { t.W = p.in[7]; t.WT = (bf16_t*)(ws + WS_W1U); t.K = DM; t.N = 2 * DFF; up = true; }
    else if ((r -= I_U) < I_D) { t.W = p.in[8]; t.WT = (bf16_t*)(ws + WS_W1D); t.K = DFF; t.N = DM; }
    else if ((r -= I_D) < I_IN) { t.W = p.in[11]; t.WT = (bf16_t*)(ws + WS_WIN); t.K = DM; t.N = INW; }
    else if ((r -= I_IN) < I_O) { t.W = p.in[27]; t.WT = (bf16_t*)(ws + WS_WOUT); t.K = DM; t.N = DM; }
    else if ((r -= I_O) < I_U) { t.W = p.in[9]; t.WT = (bf16_t*)(ws + WS_W2U); t.K = DM; t.N = 2 * DFF; up = true; }
    else { r -= I_U; t.W = p.in[10]; t.WT = (bf16_t*)(ws + WS_W2D); t.K = DFF; t.N = DM; }
    nblk = t.N / 64; t.k0 = 64 * (r / nblk); t.n0 = 64 * (r % nblk); t.drow0 = up ? up_row(t.n0) : t.n0;
    return t;
}
__device__ __forceinline__ void phase_transpose(const Params& p, LAS unsigned char* lds, int it_beg, int it_end, int bid, int nb, int wv) {
    const int tid = TIDX(wv), wave = tid >> 6, lane = tid & 63;
    LAS float* scr = (LAS float*)(lds + wave * 16640);
    const int gw = it_beg + bid * 8 + wave, NGW = nb * 8; const int NITEMS = it_end;
    float R[64];
#define TR_LOAD(t_) do { const float* src_ = (t_).W + (size_t)(t_).k0 * (t_).N + (t_).n0 + lane; _Pragma("unroll") for (int i = 0; i < 64; ++i) R[i] = src_[(size_t)i * (t_).N]; } while (0)
    if (gw < NITEMS) { const TrItem t0 = tr_decode(p, gw); TR_LOAD(t0); }
    for (int it = gw; it < NITEMS; it += NGW) {
        const TrItem t = tr_decode(p, it);
#pragma unroll
        for (int i = 0; i < 64; ++i) scr[i * 65 + lane] = R[i];
        if (it + NGW < NITEMS) { const TrItem tn = tr_decode(p, it + NGW); TR_LOAD(tn); }
        LDS_WAIT();
#pragma unroll
        for (int j = 0; j < 8; ++j) { const int item = lane + 64 * j, kc = item & 7, n = item >> 3; const LAS float* s = scr + (8 * kc) * 65 + n;
            u32x4 o; o.x = cvt_pk_bf16(s[0 * 65], s[1 * 65]); o.y = cvt_pk_bf16(s[2 * 65], s[3 * 65]); o.z = cvt_pk_bf16(s[4 * 65], s[5 * 65]); o.w = cvt_pk_bf16(s[6 * 65], s[7 * 65]);
            *(u32x4*)(t.WT + (size_t)(t.drow0 + n) * t.K + t.k0 + 8 * kc) = o; }
        LDS_WAIT();
    }
#undef TR_LOAD
    __syncthreads();
}

__device__ __forceinline__ void phase_mod(const Params& p, LAS unsigned char* lds, int bid, int nb, int wv) {
    const int tid = TIDX(wv);
    LAS float* s = (LAS float*)lds;
    LAS float* red = (LAS float*)(lds + 3 * DM * 4);
    float* mod = (float*)(p.ws + WS_MOD);
    const float* wada = p.in[4]; const float* bada = p.in[5];
    for (int strip = bid; strip < NMODC / 72; strip += nb) {
        __syncthreads();
        for (int i = tid; i < 3 * DM; i += NTHR) { const int b = i / DM, k = i - b * DM; const float v = (b < 2) ? p.in[1][b * DM + k] : p.in[3][k]; s[i] = v / (1.0f + __expf(-v)); }
        __syncthreads();
        const int cgp = tid % 18, kl = tid / 18;
        if (kl < 28) {
            f32x4 a0 = {0.f, 0.f, 0.f, 0.f}, a1 = a0, a2 = a0;
            const float* wp = wada + (size_t)strip * 72 + 4 * cgp;
            int k = kl;
            for (; k + 28 * 7 < DM; k += 28 * 8) { f32x4 w[8];
#pragma unroll
                for (int q = 0; q < 8; ++q) w[q] = *(const f32x4*)(wp + (size_t)(k + 28 * q) * NMODC);
#pragma unroll
                for (int q = 0; q < 8; ++q) { a0 += w[q] * s[k + 28 * q]; a1 += w[q] * s[DM + k + 28 * q]; a2 += w[q] * s[2 * DM + k + 28 * q]; } }
            for (; k < DM; k += 28) { const f32x4 w = *(const f32x4*)(wp + (size_t)k * NMODC); a0 += w * s[k]; a1 += w * s[DM + k]; a2 += w * s[2 * DM + k]; }
            LAS float* rp = red + (kl * 18 + cgp) * 12;
#pragma unroll
            for (int i = 0; i < 4; ++i) { rp[i] = a0[i]; rp[4 + i] = a1[i]; rp[8 + i] = a2[i]; }
        }
        __syncthreads();
        if (tid < 216) { const int cg2 = tid / 12, r = tid % 12, b = r >> 2, i = r & 3; float sum = 0.f;
            for (int q = 0; q < 28; ++q) sum += red[(q * 18 + cg2) * 12 + r];
            const int col = strip * 72 + 4 * cg2 + i; mod[(size_t)b * NMODC + col] = sum + bada[col]; }
    }
    __syncthreads();
}

__device__ __forceinline__ void phase_filter(const Params& p, LAS unsigned char* lds, int bid, int nb, int wv) {
    const int tid = TIDX(wv), wave = tid >> 6, lane = tid & 63;
    if (bid >= SEQ / 32) return;
    LAS float* W1s = (LAS float*)lds;
    LAS float* W2s = W1s + 33 * 64;
    LAS float* W3s = W2s + 64 * 64;
    LAS float* B1s = W3s + 64 * 64; LAS float* B2s = B1s + 64; LAS float* B3s = B2s + 64; LAS float* FRs = B3s + 64;
    LAS float* zs = FRs + 64;
    LAS float* ha = zs + 32 * 33;
    LAS float* hb = ha + 32 * 65;
    LAS float* h3 = (LAS float*)(lds + 65536);
    for (int i = tid; i < 33 * 64; i += NTHR) W1s[i] = p.in[16][i];
    for (int i = tid; i < 64 * 64; i += NTHR) { W2s[i] = p.in[18][i]; W3s[i] = p.in[20][i]; }
    if (tid < 64) { B1s[tid] = p.in[17][tid]; B2s[tid] = p.in[19][tid]; B3s[tid] = p.in[21][tid]; FRs[tid] = p.in[23][tid]; }
    const float* w4 = p.in[22]; const float* decay = p.in[24];
    float* hf = (float*)(p.ws + WS_HF); float* psum = (float*)(p.ws + WS_PSUM);
    for (int tile = bid; tile < SEQ / 32; tile += nb) {
        const int t0 = tile * 32;
        __syncthreads();
        { const int t = tid & 31, b = tid >> 5; const int tg = t0 + t;
          const float w = 6.283185307179586f * (float)tg / (float)SEQ;
          const float f = 1e-4f + (float)b * ((15.0f - 1e-4f) / 15.0f);
          float sn, cs; sincosf(f * w, &sn, &cs);
          zs[t * 33 + 1 + b] = cs; zs[t * 33 + 17 + b] = -sn;
          if (b == 0) zs[t * 33] = (float)tg / (float)(SEQ - 1); }
        __syncthreads();
        { const int t = tid & 31, u0 = (tid >> 5) * 4;
          f32x4 a = *(const LAS f32x4*)(B1s + u0);
#pragma unroll 11
          for (int f = 0; f < 33; ++f) { const float z = zs[t * 33 + f]; a += *(const LAS f32x4*)(W1s + f * 64 + u0) * z; }
          const f32x4 fr = *(const LAS f32x4*)(FRs + u0);
#pragma unroll
          for (int i = 0; i < 4; ++i) ha[t * 65 + u0 + i] = sinf(fr[i] * a[i]); }
        __syncthreads();
        { const int t = tid & 31, u0 = (tid >> 5) * 4;
          f32x4 a = *(const LAS f32x4*)(B2s + u0);
#pragma unroll 16
          for (int j = 0; j < 64; ++j) { const float z = ha[t * 65 + j]; a += *(const LAS f32x4*)(W2s + j * 64 + u0) * z; }
          const f32x4 fr = *(const LAS f32x4*)(FRs + u0);
#pragma unroll
          for (int i = 0; i < 4; ++i) hb[t * 65 + u0 + i] = sinf(fr[i] * a[i]); }
        __syncthreads();
        { const int t = tid & 31, u0 = (tid >> 5) * 4;
          f32x4 a = *(const LAS f32x4*)(B3s + u0);
#pragma unroll 16
          for (int j = 0; j < 64; ++j) { const float z = hb[t * 65 + j]; a += *(const LAS f32x4*)(W3s + j * 64 + u0) * z; }
          const f32x4 fr = *(const LAS f32x4*)(FRs + u0);
#pragma unroll
          for (int i = 0; i < 4; ++i) h3[t * 68 + u0 + i] = sinf(fr[i] * a[i]); }
        __syncthreads();
        { const int r32 = lane & 31, hi = lane >> 5;
          bf16x8 bh[4], bl[4];
#pragma unroll
          for (int ks = 0; ks < 4; ++ks) { const LAS float* hp = h3 + r32 * 68 + 16 * ks + 8 * hi; const f32x4 x0 = *(const LAS f32x4*)hp, x1 = *(const LAS f32x4*)(hp + 4);
              u32x4 wh, wl;
#pragma unroll
              for (int q = 0; q < 2; ++q) { const f32x4 x = q ? x1 : x0;
                  const unsigned h01 = cvt_pk_bf16(x[0], x[1]), h23 = cvt_pk_bf16(x[2], x[3]);
                  wh[2 * q] = h01; wh[2 * q + 1] = h23;
                  wl[2 * q] = cvt_pk_bf16(x[0] - bf_lo(h01), x[1] - bf_hi(h01)); wl[2 * q + 1] = cvt_pk_bf16(x[2] - bf_lo(h23), x[3] - bf_hi(h23)); }
              bh[ks] = *reinterpret_cast<bf16x8*>(&wh); bl[ks] = *reinterpret_cast<bf16x8*>(&wl); }
          const int tg = t0 + r32; const float tn = (float)tg / (float)(SEQ - 1);
#define F4_LOAD(A, ob_) do { const float* wp_ = w4 + (size_t)(8 * hi) * 2048 + 256 * wave + 32 * (ob_) + r32; \
              _Pragma("unroll") for (int ks = 0; ks < 4; ++ks) _Pragma("unroll") for (int i = 0; i < 8; ++i) A[ks][i] = wp_[(size_t)(16 * ks + i) * 2048]; } while (0)
#define F4_PROC(A, ob_) do { const int o0 = 256 * wave + 32 * (ob_); \
              float dcy[16]; _Pragma("unroll") for (int r = 0; r < 16; ++r) dcy[r] = decay[o0 + (r & 3) + 8 * (r >> 2) + 4 * hi]; \
              f32x16 acc = {}; \
              _Pragma("unroll") for (int ks = 0; ks < 4; ++ks) { u32x4 wh, wl; \
                  _Pragma("unroll") for (int q = 0; q < 4; ++q) { const float x0 = A[ks][2 * q], x1 = A[ks][2 * q + 1]; const unsigned h = cvt_pk_bf16(x0, x1); \
                      wh[q] = h; wl[q] = cvt_pk_bf16(x0 - bf_lo(h), x1 - bf_hi(h)); } \
                  const bf16x8 ah = *reinterpret_cast<bf16x8*>(&wh), al = *reinterpret_cast<bf16x8*>(&wl); \
                  acc = __builtin_amdgcn_mfma_f32_32x32x16_bf16(ah, bh[ks], acc, 0, 0, 0); \
                  acc = __builtin_amdgcn_mfma_f32_32x32x16_bf16(ah, bl[ks], acc, 0, 0, 0); \
                  acc = __builtin_amdgcn_mfma_f32_32x32x16_bf16(al, bh[ks], acc, 0, 0, 0); } \
              _Pragma("unroll") for (int r = 0; r < 16; ++r) { const int o = o0 + (r & 3) + 8 * (r >> 2) + 4 * hi; \
                  const float v = acc[r] * __expf(-tn * fabsf(dcy[r])); \
                  hf[(size_t)o * SEQ + tg] = v; \
                  float av = (o >= HYW && tg == 0) ? 0.f : fabsf(v); \
                  _Pragma("unroll") for (int m = 1; m < 32; m <<= 1) av += __shfl_xor(av, m); \
                  if (r32 == 0) psum[(size_t)o * 256 + tile] = av; } } while (0)
          float wa[4][8], wb[4][8];
          F4_LOAD(wa, 0);
          _Pragma("nounroll") for (int ob = 0; ob < 8; ob += 2) {
              F4_LOAD(wb, ob + 1);
              F4_PROC(wa, ob);
              if (ob + 2 < 8) F4_LOAD(wa, ob + 2);
              F4_PROC(wb, ob + 1);
          }
#undef F4_LOAD
#undef F4_PROC
        }
    }
    __syncthreads();
}

template <bool CTXPART>
__device__ __forceinline__ void phase_norm(const Params& p, const float* src_lat, const float* src_ctx, int nrows, const float* g, int chunk_shift, bf16_t* dst, int bid, int nb, int wv) {
    const int tid = TIDX(wv), wave = tid >> 6, lane = tid & 63;
    const float* mod = (const float*)(p.ws + WS_MOD);
#define NR_LOAD(V, r_) do { const float* xr_ = ((r_) < MLAT) ? (src_lat + (size_t)(r_) * DM) : (src_ctx + (size_t)((r_) - MLAT) * DM); \
        _Pragma("unroll") for (int j = 0; j < 8; ++j) V[j] = *(const f32x4*)(xr_ + 4 * (64 * j + lane)); } while (0)
#define NR_MAP(q_) (((nb == 256) && (q_) < MLAT) ? (2048 * ((((q_) & 2047) >> 3) & 7) + ((((q_) & 2047) >> 6) * 8 + ((q_) & 7)) + 256 * ((q_) >> 11)) : (q_))
    f32x4 vn[8];
    f32x4 gam[8], bet[8]; int cur_mi = -1;
    { const int q0 = bid * 8 + wave; if (q0 < nrows) { const int r0 = NR_MAP(q0); NR_LOAD(vn, r0); } }
    for (int q = bid * 8 + wave; q < nrows; q += nb * 8) {
        const int r = NR_MAP(q);
        const int mi = r < SEQ ? 0 : (r < MLAT ? 1 : 2);
        if (mi != cur_mi) { cur_mi = mi;
            const float* sh = mod + (size_t)mi * NMODC + (size_t)chunk_shift * DM; const float* sc = sh + DM;
#pragma unroll
            for (int j = 0; j < 8; ++j) { const int k = 4 * (64 * j + lane); gam[j] = *(const f32x4*)(g + k) * (*(const f32x4*)(sc + k) + 1.0f); bet[j] = *(const f32x4*)(sh + k); } }
        f32x4 v[8]; float ss = 0.f;
#pragma unroll
        for (int j = 0; j < 8; ++j) v[j] = vn[j];
        { const int qn = q + nb * 8; if (qn < nrows) { const int rn = NR_MAP(qn); NR_LOAD(vn, rn); } }
#pragma unroll
        for (int j = 0; j < 8; ++j) {
            if (CTXPART && r >= MLAT) {
                const float* pp = p.out + PART_OFF + (size_t)(r - MLAT) * DM + 4 * (64 * j + lane);
                f32x4 s4 = *(const f32x4*)pp;
#pragma unroll
                for (int q = 1; q < pg8::NSPLIT; ++q) s4 += *(const f32x4*)(pp + (size_t)q * MCTX * DM);
                const f32x4 g4 = *(const f32x4*)(mod + (size_t)2 * NMODC + 2 * DM + 4 * (64 * j + lane));
                v[j] = v[j] + 0.5f * g4 * s4; }
            ss += (v[j][0] * v[j][0] + v[j][1] * v[j][1]) + (v[j][2] * v[j][2] + v[j][3] * v[j][3]); }
        const float rstd = rsqrtf(wave_sum(ss) * (1.0f / DM) + EPSN);
        bf16_t* orow = dst + (size_t)r * DM;
#pragma unroll
        for (int j = 0; j < 8; ++j) { const int k = 4 * (64 * j + lane);
            const f32x4 h = (v[j] * rstd) * gam[j] + bet[j];
            u32x2 w; w.x = cvt_pk_bf16(h[0], h[1]); w.y = cvt_pk_bf16(h[2], h[3]);
            *(u32x2*)(orow + k) = w; }
    }
#undef NR_LOAD
#undef NR_MAP
}

__device__ __forceinline__ int PI(int a) { return a + (a >> 5); }
__device__ __forceinline__ f32x2 cmul(f32x2 a, f32x2 b) { const f32x2 axx = {a.x, a.x}, ayy = {a.y, a.y}, bs = {-b.y, b.x}; return axx * b + ayy * bs; }
template <bool INV> __device__ __forceinline__ f32x2 twid(float frac) { const float c = __builtin_amdgcn_cosf(frac), s = __builtin_amdgcn_sinf(frac); return (f32x2){c, INV ? s : -s}; }
template <bool INV> __device__ __forceinline__ f32x2 k16(int mp) {
    constexpr float c1 = 0.9238795325112867f, s1 = 0.3826834323650898f, c2 = 0.7071067811865476f;
    const float c = mp == 0 ? 1.f : (mp == 1 ? c1 : (mp == 2 ? c2 : s1)), s = mp == 0 ? 0.f : (mp == 1 ? s1 : (mp == 2 ? c2 : c1));
    return (f32x2){c, INV ? s : -s};
}
__device__ __forceinline__ void dif4n(f32x2& a0, f32x2& a1, f32x2& a2, f32x2& a3) {
    const f32x2 b0 = a0 + a2, b1 = a0 - a2, b2 = a1 + a3, d = a1 - a3; const f32x2 b3 = (f32x2){d.y, -d.x};
    a0 = b0 + b2; a1 = b1 + b3; a2 = b0 - b2; a3 = b1 - b3;
}
__device__ __forceinline__ void dif4w(f32x2& a0, f32x2& a1, f32x2& a2, f32x2& a3, f32x2 w1) {
    const f32x2 w2 = cmul(w1, w1), w3 = cmul(w2, w1);
    dif4n(a0, a1, a2, a3);
    a1 = cmul(a1, w1); a2 = cmul(a2, w2); a3 = cmul(a3, w3);
}
__device__ __forceinline__ void dit4n(f32x2& a0, f32x2& a1, f32x2& a2, f32x2& a3) {
    const f32x2 b0 = a0 + a2, b1 = a0 - a2, b2 = a1 + a3, d = a1 - a3; const f32x2 b3 = (f32x2){-d.y, d.x};
    a0 = b0 + b2; a1 = b1 + b3; a2 = b0 - b2; a3 = b1 - b3;
}
__device__ __forceinline__ void dit4w(f32x2& a0, f32x2& a1, f32x2& a2, f32x2& a3, f32x2 w1) {
    const f32x2 w2 = cmul(w1, w1), w3 = cmul(w2, w1);
    a1 = cmul(a1, w1); a2 = cmul(a2, w2); a3 = cmul(a3, w3);
    dit4n(a0, a1, a2, a3);
}
template <bool J0> __device__ __forceinline__ void r16_fwd(f32x2 (&e)[16], f32x2 w) {
#pragma unroll
    for (int mp = 0; mp < 4; ++mp) {
        if (J0 && mp == 0) dif4n(e[0], e[4], e[8], e[12]);
        else dif4w(e[mp], e[mp + 4], e[mp + 8], e[mp + 12], J0 ? k16<false>(mp) : (mp == 0 ? w : cmul(w, k16<false>(mp))));
    }
    f32x2 w4 = w; if (!J0) { w4 = cmul(w, w); w4 = cmul(w4, w4); }
#pragma unroll
    for (int k = 0; k < 4; ++k) { if (J0) dif4n(e[4 * k], e[4 * k + 1], e[4 * k + 2], e[4 * k + 3]); else dif4w(e[4 * k], e[4 * k + 1], e[4 * k + 2], e[4 * k + 3], w4); }
}
template <bool J0> __device__ __forceinline__ void r16_inv(f32x2 (&e)[16], f32x2 w) {
    f32x2 w4 = w; if (!J0) { w4 = cmul(w, w); w4 = cmul(w4, w4); }
#pragma unroll
    for (int k = 0; k < 4; ++k) { if (J0) dit4n(e[4 * k], e[4 * k + 1], e[4 * k + 2], e[4 * k + 3]); else dit4w(e[4 * k], e[4 * k + 1], e[4 * k + 2], e[4 * k + 3], w4); }
#pragma unroll
    for (int mp = 0; mp < 4; ++mp) {
        if (J0 && mp == 0) dit4n(e[0], e[4], e[8], e[12]);
        else dit4w(e[mp], e[mp + 4], e[mp + 8], e[mp + 12], J0 ? k16<true>(mp) : (mp == 0 ? w : cmul(w, k16<true>(mp))));
    }
}
template <bool INV> __device__ __forceinline__ void fft_passB(LAS f32x2* X, int wv) {
    const int tid = TIDX(wv);
    _Pragma("nounroll") for (int it = 0; it < 2; ++it) { const int u = tid + NTHR * it, blk = u >> 6, j = u & 63; const int a0 = PI(blk * 1024 + j);
        f32x2 e[16];
#pragma unroll
        for (int m = 0; m < 16; ++m) e[m] = X[a0 + 66 * m];
        const f32x2 w = twid<INV>((float)j * (1.0f / 1024.0f));
        if (!INV) r16_fwd<false>(e, w); else r16_inv<false>(e, w);
#pragma unroll
        for (int m = 0; m < 16; ++m) X[a0 + 66 * m] = e[m]; }
}
template <bool INV> __device__ __forceinline__ void fft_passC(LAS f32x2* X, int wv) {
    const int tid = TIDX(wv);
    _Pragma("nounroll") for (int it = 0; it < 8; ++it) { const int u = tid + NTHR * it, blk = u >> 4, j = u & 15; const int a = blk * 66 + j;
        f32x2 e0 = X[a], e1 = X[a + 16], e2 = X[a + 33], e3 = X[a + 49];
        const f32x2 w = twid<INV>((float)j * (1.0f / 64.0f));
        if (!INV) dif4w(e0, e1, e2, e3, w); else dit4w(e0, e1, e2, e3, w);
        X[a] = e0; X[a + 16] = e1; X[a + 33] = e2; X[a + 49] = e3; }
}

__device__ __forceinline__ int rev4_7(int x) {
    unsigned r = (unsigned)x;
    r = ((r & 0x3333u) << 2) | ((r >> 2) & 0x3333u);
    r = ((r & 0x0F0Fu) << 4) | ((r >> 4) & 0x0F0Fu);
    r = ((r & 0x00FFu) << 8) | ((r >> 8) & 0x00FFu);
    return (int)(r >> 2);
}
__device__ __forceinline__ void phase_filter_fft(const Params& p, LAS unsigned char* lds, int bid, int nb, int wv) {
    const int tid = TIDX(wv), lane = tid & 63, wave = tid >> 6;
    LAS f32x2* X = (LAS f32x2*)lds;
    LAS float* red = (LAS float*)(lds + 135168);
    const float* hf = (const float*)(p.ws + WS_HF); const float* psum = (const float*)(p.ws + WS_PSUM);
    unsigned* Kf = (unsigned*)p.out;
    for (int c = bid; c < HYW / 2; c += nb) {
        const int c2 = c + HYW / 2;
        __syncthreads();
        float a1 = 0.f, a2 = 0.f;
        if (tid < 256) { a1 = psum[(size_t)c * 256 + tid] + psum[(size_t)(HYW + c) * 256 + tid]; a2 = psum[(size_t)c2 * 256 + tid] + psum[(size_t)(HYW + c2) * 256 + tid]; }
        a1 = wave_sum(a1); a2 = wave_sum(a2);
        if (lane == 0) { red[wave] = a1; red[8 + wave] = a2; }
        __syncthreads();
        const float s1 = 1.0f / ((red[0] + red[1]) + (red[2] + red[3])), s2 = 1.0f / ((red[8] + red[9]) + (red[10] + red[11]));
        const float* kf1 = hf + (size_t)c * SEQ; const float* kb1 = hf + (size_t)(HYW + c) * SEQ;
        const float* kf2 = hf + (size_t)c2 * SEQ; const float* kb2 = hf + (size_t)(HYW + c2) * SEQ;
_Pragma("nounroll") for (int it = 0; it < 2; ++it) { const int j = tid + NTHR * it; const int a0 = PI(j);
            f32x2 e[16];
#pragma unroll
            for (int m = 0; m < 8; ++m) e[m] = (f32x2){kf1[j + 1024 * m] * s1, kf2[j + 1024 * m] * s2};
#pragma unroll
            for (int m = 8; m < 16; ++m) { const int n = j + 1024 * m; const int ix = (n == SEQ) ? 1 : (FFTN - n);
                e[m] = (n == SEQ) ? (f32x2){0.f, 0.f} : (f32x2){kb1[ix] * s1, kb2[ix] * s2}; }
            r16_fwd<false>(e, twid<false>((float)j * (1.0f / 16384.0f)));
#pragma unroll
            for (int m = 0; m < 16; ++m) X[a0 + 1056 * m] = e[m]; }
        __syncthreads();
        fft_passB<false>(X, wv);
        __syncthreads();
        fft_passC<false>(X, wv);
        __syncthreads();
        _Pragma("nounroll") for (int it = 0; it < 2; ++it) { const int u = tid + NTHR * it; const int a0 = 16 * u + (u >> 1);
            f32x2 e[16];
#pragma unroll
            for (int m = 0; m < 16; ++m) e[m] = X[a0 + m];
            r16_fwd<true>(e, (f32x2){1.f, 0.f});
#pragma unroll
            for (int m = 0; m < 16; ++m) X[a0 + m] = e[m] * (0.5f / (float)FFTN); }
        __syncthreads();
        unsigned* d1 = Kf + (size_t)c * FFTN; unsigned* d2 = Kf + (size_t)c2 * FFTN;
        _Pragma("nounroll") for (int it = 0; it < FFTN / NTHR; ++it) { const int q = tid + NTHR * it;
            const int k = rev4_7(q), q2 = rev4_7((FFTN - k) & (FFTN - 1));
            const f32x2 a = X[PI(q)], b = X[PI(q2)];
            d1[q] = cvt_pk_bf16(a.x + b.x, a.y - b.y);
            d2[q] = cvt_pk_bf16(a.y + b.y, b.x - a.x); }
    }
    __syncthreads();
}

__device__ __forceinline__ void phase_prep_qkv(const Params& p, int bid, int nb, int wv) {
    const int tid = TIDX(wv), wave = tid >> 6, lane = tid & 63;
    const bf16_t* P = (const bf16_t*)(p.ws + WS_P);
    bf16_t* Q = (bf16_t*)(p.ws + WS_Q); bf16_t* Kd = (bf16_t*)(p.ws + WS_K); bf16_t* Vd = (bf16_t*)(p.ws + WS_V);
    const float qn0 = p.in[12][2 * lane], qn1 = p.in[12][2 * lane + 1], kn0 = p.in[13][2 * lane], kn1 = p.in[13][2 * lane + 1];
    const float inv = exp2f(-(float)(2 * (lane & 31)) * (13.287712379549449f / 64.0f));
#define QK_LOAD(W, r_) do { const unsigned* pr_ = (const unsigned*)(P + (size_t)(r_) * INW); \
        _Pragma("unroll") for (int h = 0; h < 12; ++h) W[h] = pr_[h * 64 + lane]; } while (0)
    unsigned wn[12];
    { const int r0 = bid * 8 + wave; if (r0 < MTOT) QK_LOAD(wn, r0); }
    for (int r = bid * 8 + wave; r < MTOT; r += nb * 8) {
        unsigned prow[12];
#pragma unroll
        for (int h = 0; h < 12; ++h) prow[h] = wn[h];
        { const int rn = r + nb * 8; if (rn < MTOT) QK_LOAD(wn, rn); }
        const bool lat = r < MLAT;
        int b, t; float cs = 1.f, sn = 0.f;
        if (lat) { b = r / SEQ; t = r - b * SEQ; const int pos = (lane < 32) ? (t >> 6) : (t & 63); const float fr = (float)pos * (inv * 0.15915494309189535f); sn = __builtin_amdgcn_sinf(fr); cs = __builtin_amdgcn_cosf(fr); }
        else { b = (r - MLAT) / CTXL; t = (r - MLAT) - b * CTXL; }
        const int kpos = lat ? (CTXL + t) : t;
        if (lat) {
#pragma unroll
            for (int h = 0; h < NQH; ++h) { const unsigned w = prow[h]; const float x0 = bf_lo(w), x1 = bf_hi(w);
                const float rs = rsqrtf(wave_sum(x0 * x0 + x1 * x1) * (1.0f / HD) + EPSN);
                const float y0 = x0 * rs * qn0, y1 = x1 * rs * qn1;
                *(unsigned*)(Q + ((size_t)(b * NQH + h) * SEQ + t) * HD + 2 * lane) = cvt_pk_bf16(y0 * cs - y1 * sn, y0 * sn + y1 * cs); }
        }
#pragma unroll
        for (int h = 0; h < NKVH; ++h) { const unsigned w = prow[8 + h]; const float x0 = bf_lo(w), x1 = bf_hi(w);
            const float rs = rsqrtf(wave_sum(x0 * x0 + x1 * x1) * (1.0f / HD) + EPSN);
            const float y0 = x0 * rs * kn0, y1 = x1 * rs * kn1;
            *(unsigned*)(Kd + ((size_t)(b * NKVH + h) * LKEYS + kpos) * HD + 2 * lane) = cvt_pk_bf16(y0 * cs - y1 * sn, y0 * sn + y1 * cs);
            *(unsigned*)(Vd + ((size_t)(b * NKVH + h) * LKEYS + kpos) * HD + 2 * lane) = prow[10 + h]; }
    }
}

__device__ __forceinline__ void phase_prep_hyena(const Params& p, LAS unsigned char* lds, int bid, int nb, int wv) {
    const int tid = TIDX(wv), wave = tid >> 6, lane = tid & 63;
    const bf16_t* P = (const bf16_t*)(p.ws + WS_P);
    bf16_t* vxT = (bf16_t*)(p.ws + WS_VXT); bf16_t* x0T = (bf16_t*)(p.ws + WS_X0T);
    const float* cw = p.in[14]; const float* cb = p.in[15];
    LAS float* vxs = (LAS float*)lds; LAS float* x0s = vxs + 128 * 65;
    constexpr int NCB = HYW / 128, NTB = NBATCH * (SEQ / 64);
    for (int w0i = bid; w0i < NCB * 32; w0i += nb) {
        const int cblk = w0i & (NCB - 1), strand = w0i >> 3;
        const int c2 = cblk * 128 + 2 * lane;
        float wt[3][2][4];
#pragma unroll
        for (int part = 0; part < 3; ++part)
#pragma unroll
            for (int ch = 0; ch < 2; ++ch) { const int col = part * HYW + c2 + ch; wt[part][ch][0] = cw[col]; wt[part][ch][1] = cw[3 * HYW + col]; wt[part][ch][2] = cw[6 * HYW + col]; wt[part][ch][3] = cb[col]; }
#define HY_LOAD(U, g_) do { const int b_ = (g_) >> 7, tw_ = ((g_) & 127) * 64 + wave * 8; _Pragma("unroll") for (int part = 0; part < 3; ++part) _Pragma("unroll") for (int i = 0; i < 10; ++i) { \
        const int tt = tw_ + i - 1; U[part][i] = (tt >= 0 && tt < SEQ) ? *(const unsigned*)(P + (size_t)(b_ * SEQ + tt) * INW + (ATW + 2 * NKVH * HD) + part * HYW + c2) : 0u; } } while (0)
#define HY_PROC(U, g_) do { const int b_ = (g_) >> 7, tb_ = (g_) & 127; float uc[3][8][2]; \
        _Pragma("unroll") for (int part = 0; part < 3; ++part) _Pragma("unroll") for (int i = 0; i < 8; ++i) { \
            uc[part][i][0] = bf_lo(U[part][i]) * wt[part][0][0] + bf_lo(U[part][i + 1]) * wt[part][0][1] + bf_lo(U[part][i + 2]) * wt[part][0][2] + wt[part][0][3]; \
            uc[part][i][1] = bf_hi(U[part][i]) * wt[part][1][0] + bf_hi(U[part][i + 1]) * wt[part][1][1] + bf_hi(U[part][i + 2]) * wt[part][1][2] + wt[part][1][3]; } \
        __syncthreads(); \
        _Pragma("unroll") for (int i = 0; i < 8; ++i) _Pragma("unroll") for (int ch = 0; ch < 2; ++ch) { \
            vxs[(2 * lane + ch) * 65 + wave * 8 + i] = uc[2][i][ch] * uc[1][i][ch]; x0s[(2 * lane + ch) * 65 + wave * 8 + i] = uc[0][i][ch]; } \
        __syncthreads(); \
        { const int cc = tid >> 2, seg = tid & 3; const LAS float* a = vxs + cc * 65 + seg * 16; const LAS float* d = x0s + cc * 65 + seg * 16; \
          const size_t o = (size_t)(cblk * 128 + cc) * MLAT + (size_t)b_ * SEQ + tb_ * 64 + seg * 16; \
          _Pragma("unroll") for (int h = 0; h < 2; ++h) { u32x4 wa, wd; \
              wa.x = cvt_pk_bf16(a[8 * h + 0], a[8 * h + 1]); wa.y = cvt_pk_bf16(a[8 * h + 2], a[8 * h + 3]); wa.z = cvt_pk_bf16(a[8 * h + 4], a[8 * h + 5]); wa.w = cvt_pk_bf16(a[8 * h + 6], a[8 * h + 7]); \
              wd.x = cvt_pk_bf16(d[8 * h + 0], d[8 * h + 1]); wd.y = cvt_pk_bf16(d[8 * h + 2], d[8 * h + 3]); wd.z = cvt_pk_bf16(d[8 * h + 4], d[8 * h + 5]); wd.w = cvt_pk_bf16(d[8 * h + 6], d[8 * h + 7]); \
              *(u32x4*)(vxT + o + 8 * h) = wa; *(u32x4*)(x0T + o + 8 * h) = wd; } } } while (0)
        unsigned UA[3][10], UB[3][10];
        HY_LOAD(UA, strand);
        _Pragma("nounroll") for (int g = strand; g < NTB; g += 64) {
            if (g + 32 < NTB) HY_LOAD(UB, g + 32);
            HY_PROC(UA, g);
            if (g + 32 < NTB) { if (g + 64 < NTB) HY_LOAD(UA, g + 64); HY_PROC(UB, g + 32); }
        }
#undef HY_LOAD
#undef HY_PROC
    }
    __syncthreads();
}

__device__ __forceinline__ void phase_attention(const Params& p, unsigned char* lds_g, int bid, int nb, int wv) {
    const bf16_t* Q = (const bf16_t*)(p.ws + WS_Q); const bf16_t* Kd = (const bf16_t*)(p.ws + WS_K); const bf16_t* Vd = (const bf16_t*)(p.ws + WS_V);
    float* O = (float*)(p.ws + WS_ATTN);
    constexpr int NU = NBATCH * NQH * (SEQ / 256);
    for (int u = bid; u < NU; u += nb) {
        const int b = u >> 8, w = u & 255, x = w & 7, i = w >> 3;
        const int kvh = x >> 2, qh = kvh * 4 + (x & 3), qblk = i;
        __syncthreads();
        att::attn_dense_body(Q + ((size_t)(b * NQH + qh) * SEQ + qblk * 256) * HD, Kd + (size_t)(b * NKVH + kvh) * LKEYS * HD, Vd + (size_t)(b * NKVH + kvh) * LKEYS * HD,
                             O + ((size_t)b * SEQ + qblk * 256) * ATW + qh * HD, LKEYS, (char*)lds_g, wv);
    }
    __syncthreads();
}

__device__ __forceinline__ void phase_hyena_conv(const Params& p, LAS unsigned char* lds, int bid, int nb, int wv) {
    const int tid = TIDX(wv);
    LAS f32x2* X = (LAS f32x2*)lds;
    const bf16_t* vxT = (const bf16_t*)(p.ws + WS_VXT); const bf16_t* x0T = (const bf16_t*)(p.ws + WS_X0T);
    bf16_t* hyoT = (bf16_t*)(p.ws + WS_HYOT);
    const unsigned* Kf = (const unsigned*)p.out;
#define CV_LOADX(XR, c_) do { const bf16_t* a_ = vxT + (size_t)(c_) * MLAT + tid; const bf16_t* b_ = a_ + SEQ; \
        _Pragma("unroll") for (int it = 0; it < 2; ++it) _Pragma("unroll") for (int m = 0; m < 8; ++m) XR[it][m] = (unsigned)a_[NTHR * it + 1024 * m] | ((unsigned)b_[NTHR * it + 1024 * m] << 16); } while (0)
    unsigned xnext[2][8];
    if (bid < HYW) CV_LOADX(xnext, bid);
    for (int c = bid; c < HYW; c += nb) {
        __syncthreads();
        const unsigned* kf = Kf + (size_t)c * FFTN;
        unsigned xcur[2][8];
#pragma unroll
        for (int it = 0; it < 2; ++it)
#pragma unroll
            for (int m = 0; m < 8; ++m) xcur[it][m] = xnext[it][m];
        u32x4 kq[2][4];
#pragma unroll
        for (int it = 0; it < 2; ++it)
#pragma unroll
            for (int m = 0; m < 4; ++m) kq[it][m] = *(const u32x4*)(kf + 16 * (tid + NTHR * it) + 4 * m);
        _Pragma("nounroll") for (int it = 0; it < 2; ++it) { const int j = tid + NTHR * it; const int a0 = PI(j);
            f32x2 e[16];
            const f32x2 w = twid<false>((float)j * (1.0f / 16384.0f));
#pragma unroll
            for (int mp = 0; mp < 4; ++mp) { const unsigned r0 = it ? xcur[1][mp] : xcur[0][mp], r1 = it ? xcur[1][mp + 4] : xcur[0][mp + 4];
                const f32x2 x0 = (f32x2){bf_lo(r0), bf_hi(r0)}, x1 = (f32x2){bf_lo(r1), bf_hi(r1)};
                const f32x2 r = (f32x2){x1.y, -x1.x};
                const f32x2 w1 = (mp == 0) ? w : cmul(w, k16<false>(mp)), w2 = cmul(w1, w1), w3 = cmul(w2, w1);
                e[mp] = x0 + x1; e[mp + 4] = cmul(x0 + r, w1); e[mp + 8] = cmul(x0 - x1, w2); e[mp + 12] = cmul(x0 - r, w3); }
            f32x2 w4 = cmul(w, w); w4 = cmul(w4, w4);
#pragma unroll
            for (int k = 0; k < 4; ++k) dif4w(e[4 * k], e[4 * k + 1], e[4 * k + 2], e[4 * k + 3], w4);
#pragma unroll
            for (int m = 0; m < 16; ++m) X[a0 + 1056 * m] = e[m]; }
        __syncthreads();
        fft_passB<false>(X, wv);
        __syncthreads();
        fft_passC<false>(X, wv);
        __syncthreads();
        _Pragma("nounroll") for (int it = 0; it < 2; ++it) { const int u = tid + NTHR * it; const int a0 = 16 * u + (u >> 1);
            f32x2 e[16];
#pragma unroll
            for (int m = 0; m < 16; ++m) e[m] = X[a0 + m];
            r16_fwd<true>(e, (f32x2){1.f, 0.f});
#pragma unroll
            for (int m = 0; m < 16; ++m) { const unsigned kw = it ? kq[1][m >> 2][m & 3] : kq[0][m >> 2][m & 3]; e[m] = cmul(e[m], (f32x2){bf_lo(kw), bf_hi(kw)}); }
            r16_inv<true>(e, (f32x2){1.f, 0.f});
#pragma unroll
            for (int m = 0; m < 16; ++m) X[a0 + m] = e[m]; }
        if (c + nb < HYW) CV_LOADX(xnext, c + nb);
        unsigned egg[2][8];
        { const bf16_t* g0 = x0T + (size_t)c * MLAT + tid; const bf16_t* g1 = g0 + SEQ;
#pragma unroll
          for (int it = 0; it < 2; ++it)
#pragma unroll
              for (int m = 0; m < 8; ++m) egg[it][m] = (unsigned)g0[NTHR * it + 1024 * m] | ((unsigned)g1[NTHR * it + 1024 * m] << 16); }
        __syncthreads();
        fft_passC<true>(X, wv);
        __syncthreads();
        fft_passB<true>(X, wv);
        __syncthreads();
        const float hb = p.in[25][c];
        bf16_t* o0 = hyoT + (size_t)c * MLAT; bf16_t* o1 = o0 + SEQ;
        _Pragma("nounroll") for (int it = 0; it < 2; ++it) { const int j = tid + NTHR * it; const int a0 = PI(j);
            f32x2 e[16];
#pragma unroll
            for (int m = 0; m < 16; ++m) e[m] = X[a0 + 1056 * m];
            const f32x2 w = twid<true>((float)j * (1.0f / 16384.0f));
            f32x2 w4 = cmul(w, w); w4 = cmul(w4, w4);
#pragma unroll
            for (int k = 0; k < 4; ++k) dit4w(e[4 * k], e[4 * k + 1], e[4 * k + 2], e[4 * k + 3], w4);
#pragma unroll
            for (int mp = 0; mp < 4; ++mp) { const f32x2 w1 = (mp == 0) ? w : cmul(w, k16<true>(mp)), w2 = cmul(w1, w1), w3 = cmul(w2, w1);
                const f32x2 c0 = e[mp], c1 = cmul(e[mp + 4], w1), c2 = cmul(e[mp + 8], w2), c3 = cmul(e[mp + 12], w3);
                const f32x2 b0 = c0 + c2, b1 = c0 - c2, b2 = c1 + c3, d = c1 - c3; const f32x2 b3 = (f32x2){-d.y, d.x};
                const f32x2 y0 = b0 + b2, y1 = b1 + b3;
                const int t0 = j + 1024 * mp, t1 = t0 + 4096;
                const unsigned va = it ? xcur[1][mp] : xcur[0][mp], vb = it ? xcur[1][mp + 4] : xcur[0][mp + 4];
                const unsigned ga = it ? egg[1][mp] : egg[0][mp], gb = it ? egg[1][mp + 4] : egg[0][mp + 4];
                const unsigned ra = cvt_pk_bf16((y0.x + hb * bf_lo(va)) * bf_lo(ga), (y0.y + hb * bf_hi(va)) * bf_hi(ga)), rb = cvt_pk_bf16((y1.x + hb * bf_lo(vb)) * bf_lo(gb), (y1.y + hb * bf_hi(vb)) * bf_hi(gb));
                o0[t0] = (bf16_t)(ra & 0xffffu); o1[t0] = (bf16_t)(ra >> 16); o0[t1] = (bf16_t)(rb & 0xffffu); o1[t1] = (bf16_t)(rb >> 16); }
        }
    }
#undef CV_LOADX
    __syncthreads();
}

__device__ __forceinline__ void phase_merge(const Params& p, LAS unsigned char* lds, int bid, int nb, int wv) {
    const int tid = TIDX(wv), wave = tid >> 6, lane = tid & 63;
    const float* attn = (const float*)(p.ws + WS_ATTN); const bf16_t* hyoT = (const bf16_t*)(p.ws + WS_HYOT);
    bf16_t* Y = (bf16_t*)(p.ws + WS_HA);
    const float* gout = p.in[26];
    LAS float* ts = (LAS float*)lds;
    LAS float* part = ts + 128 * 65;
    LAS float* rh = part + 8 * 64;
#define MG_LOAD(V, ch_) do { const bf16_t* hp_ = hyoT + (size_t)((ch_) * 128 + wave * 16) * MLAT + tok0 + lane; _Pragma("unroll") for (int i = 0; i < 16; ++i) V[i] = hp_[(size_t)i * MLAT]; } while (0)
#define MG_PROC(V, ch_) do { const int c0_ = (ch_) * 128; const float rr_ = rh[lane]; \
        _Pragma("unroll") for (int i = 0; i < 16; ++i) ts[(wave * 16 + i) * 65 + lane] = bf2f(V[i]) * rr_ * gout[ATW + c0_ + wave * 16 + i]; \
        __syncthreads(); \
        _Pragma("unroll") for (int it = 0; it < 2; ++it) { const int item = tid + NTHR * it; const int tok = item >> 4, chunk = item & 15; \
            const LAS float* s = ts + (chunk * 8) * 65 + tok; \
            u32x4 w; w.x = cvt_pk_bf16(s[0], s[65]); w.y = cvt_pk_bf16(s[2 * 65], s[3 * 65]); w.z = cvt_pk_bf16(s[4 * 65], s[5 * 65]); w.w = cvt_pk_bf16(s[6 * 65], s[7 * 65]); \
            *(u32x4*)(Y + (size_t)(tok0 + tok) * DM + ATW + c0_ + chunk * 8) = w; } \
        __syncthreads(); } while (0)
    for (int tile = bid; tile < MLAT / 64; tile += nb) {
        const int tok0 = tile * 64;
        __syncthreads();
        { float ss = 0.f; const bf16_t* hp = hyoT + (size_t)(wave * 128) * MLAT + tok0 + lane;
#pragma unroll
          for (int cq = 0; cq < 2; ++cq) { bf16_t hv[64];
#pragma unroll
              for (int cc = 0; cc < 64; ++cc) hv[cc] = hp[(size_t)(cq * 64 + cc) * MLAT];
#pragma unroll
              for (int cc = 0; cc < 64; ++cc) { const float v = bf2f(hv[cc]); ss += v * v; } }
          part[wave * 64 + lane] = ss; }
        f32x4 ggv[4];
#pragma unroll
        for (int j = 0; j < 4; ++j) ggv[j] = *(const f32x4*)(gout + 4 * (64 * j + lane));
#pragma unroll
        for (int half = 0; half < 2; ++half) {
            f32x4 v[4][4];
#pragma unroll
            for (int i = 0; i < 4; ++i) { const float* ar = attn + (size_t)(tok0 + wave * 8 + half * 4 + i) * ATW;
#pragma unroll
                for (int j = 0; j < 4; ++j) v[i][j] = *(const f32x4*)(ar + 4 * (64 * j + lane)); }
#pragma unroll
            for (int i = 0; i < 4; ++i) { const int tok = tok0 + wave * 8 + half * 4 + i; float ss = 0.f;
#pragma unroll
                for (int j = 0; j < 4; ++j) ss += (v[i][j][0] * v[i][j][0] + v[i][j][1] * v[i][j][1]) + (v[i][j][2] * v[i][j][2] + v[i][j][3] * v[i][j][3]);
                const float rs = rsqrtf(wave_sum(ss) * (1.0f / ATW) + EPSN);
#pragma unroll
                for (int j = 0; j < 4; ++j) { const int k = 4 * (64 * j + lane); const f32x4 h = v[i][j] * rs * ggv[j];
                    u32x2 w; w.x = cvt_pk_bf16(h[0], h[1]); w.y = cvt_pk_bf16(h[2], h[3]); *(u32x2*)(Y + (size_t)tok * DM + k) = w; } }
        }
        __syncthreads();
        if (tid < 64) { float s = 0.f; for (int w = 0; w < 8; ++w) s += part[w * 64 + tid]; rh[tid] = rsqrtf(s * (1.0f / HYW) + EPSN); }
        __syncthreads();
        bf16_t va[16], vb[16];
        MG_LOAD(va, 0);
        _Pragma("nounroll") for (int ch = 0; ch < 8; ch += 2) {
            MG_LOAD(vb, ch + 1);
            MG_PROC(va, ch);
            if (ch + 2 < 8) MG_LOAD(va, ch + 2);
            MG_PROC(vb, ch + 1);
        }
    }
#undef MG_LOAD
#undef MG_PROC
    __syncthreads();
}

constexpr size_t WS_BAR = 512 * 1024;
constexpr int LDS_BARST = LDS_BYTES - 64;
#define XB_TMO      128
#define XB_XCNT(j)  (256  + 64 * (j))
#define XB_XSUB(j)  (1280 + 64 * (j))
#define XB_XGEN(j)  (2304 + 64 * (j))
#define XB_TOP      3328
#define XB_TOPGEN   3392
#define XCD_BAR_WORDS 3456
#define XB_SPIN_CAP (1u << 18)
__device__ __forceinline__ unsigned xb_ld(unsigned* p)              { return __hip_atomic_load(p, __ATOMIC_RELAXED, __HIP_MEMORY_SCOPE_AGENT); }
__device__ __forceinline__ unsigned xb_add(unsigned* p, unsigned v) { return __hip_atomic_fetch_add(p, v, __ATOMIC_RELAXED, __HIP_MEMORY_SCOPE_AGENT); }
__device__ __forceinline__ unsigned xb_xcc_id() { return (unsigned)__builtin_amdgcn_s_getreg((3 << 11) | 20) & 0xFu; }
#define XB_SPIN(cond, bar) do { unsigned _sp = 0; while (cond) { __builtin_amdgcn_s_sleep(1); \
    if ((++_sp & 255u) == 0u) { if (xb_ld(&(bar)[XB_TMO])) break; if (_sp > XB_SPIN_CAP) { atomicAdd(&(bar)[XB_TMO], 1u); break; } } } } while (0)
struct XcdBarrier { unsigned* bar; unsigned x; volatile LAS unsigned* st; };
__device__ __forceinline__ XcdBarrier xcd_barrier_post(unsigned* bar, volatile LAS unsigned* st, int tid) {
    XcdBarrier b; b.bar = bar; b.x = xb_xcc_id(); b.st = st;
    if (tid == 0) (void)xb_add(&bar[XB_XCNT(b.x)], 1u);
    return b;
}
__device__ __forceinline__ void xcd_barrier_complete(unsigned* bar, unsigned x, unsigned& nloc, unsigned& nx) {
    const unsigned G = gridDim.x * gridDim.y * gridDim.z;
    unsigned sum, cnt, mine, sp = 0u;
    for (;;) {
        sum = 0u; cnt = 0u; mine = 0u;
#pragma unroll
        for (unsigned j = 0; j < 16; ++j) { const unsigned c = xb_ld(&bar[XB_XCNT(j)]); sum += c; cnt += (c > 0u) ? 1u : 0u; mine = (j == x) ? c : mine; }
        if (sum == G) break;
        __builtin_amdgcn_s_sleep(1);
        if ((++sp & 255u) == 0u) { if (xb_ld(&bar[XB_TMO])) break; if (sp > XB_SPIN_CAP) { atomicAdd(&bar[XB_TMO], 1u); break; } }
    }
    nloc = mine > 0u ? mine : 1u; nx = cnt > 0u ? cnt : 1u;
}
__device__ __forceinline__ void xcd_barrier(const XcdBarrier& b, int wv) {
    asm volatile("s_waitcnt vmcnt(0)" ::: "memory");
    __syncthreads();
    if (TIDX(wv) == 0) {
        unsigned* bar = b.bar;
        __builtin_amdgcn_s_waitcnt(0);
        unsigned nloc = b.st[0], nx = b.st[1];
        if (nloc == 0u) { xcd_barrier_complete(bar, b.x, nloc, nx); b.st[0] = nloc; b.st[1] = nx; }
        const unsigned old = xb_add(&bar[XB_XSUB(b.x)], 1u);
        const unsigned gen = old / nloc;
        if (old + 1u == (gen + 1u) * nloc) {
            __builtin_amdgcn_fence(__ATOMIC_RELEASE, "agent");
            asm volatile("s_waitcnt vmcnt(0)" ::: "memory");
            const unsigned og = xb_add(&bar[XB_TOP], 1u);
            const unsigned tg = og / nx;
            if (og + 1u == (tg + 1u) * nx) xb_add(&bar[XB_TOPGEN], 1u);
            else XB_SPIN(xb_ld(&bar[XB_TOPGEN]) == tg, bar);
            __builtin_amdgcn_fence(__ATOMIC_ACQUIRE, "agent");
            xb_add(&bar[XB_XGEN(b.x)], 1u);
            asm volatile("s_waitcnt vmcnt(0)" ::: "memory");
        } else {
            XB_SPIN(xb_ld(&bar[XB_XGEN(b.x)]) == gen, bar);
            __builtin_amdgcn_fence(__ATOMIC_ACQUIRE, "agent");
            asm volatile("s_waitcnt vmcnt(0)" ::: "memory");
        }
    }
    __syncthreads();
}

constexpr int TR_SPLIT = (DM / 64) * (2 * DFF / 64) + (DFF / 64) * (DM / 64) + (DM / 64) * (INW / 64);
constexpr int TR_ALL = TR_SPLIT + (DM / 64) * (DM / 64) + (DM / 64) * (2 * DFF / 64) + (DFF / 64) * (DM / 64);
constexpr int NPHASE = 13;
__global__ void __launch_bounds__(NTHR, 2) mk_fwd(Params p) {
    extern __shared__ __attribute__((aligned(16))) unsigned char lds_g[];
    LAS unsigned char* lds = (LAS unsigned char*)lds_g;
    const int bid = blockIdx.x, nb = gridDim.x;
    const int wv = __builtin_amdgcn_readfirstlane(threadIdx.x >> 6);
    const int lo = p.ph_lo, hi = p.ph_hi;
    unsigned char* ws = p.ws;
    float* modp = (float*)(ws + WS_MOD);
    bf16_t* HA = (bf16_t*)(ws + WS_HA); bf16_t* ACT = (bf16_t*)(ws + WS_ACT); float* X1 = (float*)(ws + WS_X1);
#define IN(k) (lo <= (k) && (k) < hi)
#define VB(k) ((((p.dup_mask >> (k)) & 1) ? (bid >> 1) : bid))
#define VN(k) ((((p.dup_mask >> (k)) & 1) ? (nb >> 1) : nb))
#define VB2(k, j) ((((p.dup_mask >> (k)) | (p.dup_mask >> (j))) & 1) ? (bid >> 1) : bid)
#define VN2(k, j) ((((p.dup_mask >> (k)) | (p.dup_mask >> (j))) & 1) ? (nb >> 1) : nb)
#define SEAM(k) do { if (IN(k) && IN((k) + 1)) { xcd_barrier(bar, wv); } } while (0)
    if (p.ph_lo < 0) cg::this_grid().sync();
    XcdBarrier bar; bar.bar = (unsigned*)(ws + WS_BAR); bar.x = 0; bar.st = (volatile LAS unsigned*)(lds + LDS_BARST);
    if (hi - lo > 1) { if (TIDX(wv) == 0) { bar.st[0] = 0u; bar.st[1] = 0u; } __syncthreads(); bar = xcd_barrier_post((unsigned*)(ws + WS_BAR), (volatile LAS unsigned*)(lds + LDS_BARST), TIDX(wv)); }
    if (IN(0)) { phase_transpose(p, lds, 0, TR_SPLIT, VB2(0, 16), VN2(0, 16), wv); phase_mod(p, lds, VB2(0, 17), VN2(0, 17), wv); phase_filter(p, lds, (VB2(0, 15) + VN2(0, 15) / 2) % VN2(0, 15), VN2(0, 15), wv); }
    SEAM(0);
    if (IN(1)) { phase_norm<false>(p, p.in[0], p.in[2], MTOT, p.in[6], 0, HA, VB(1), VN(1), wv); phase_filter_fft(p, lds, VB2(1, 14), VN2(1, 14), wv); }
    SEAM(1);
    if (IN(2)) { pg8::Gemm g{HA, (const bf16_t*)(ws + WS_W1U), MTOT, 2 * DFF, DM, DM}; pg8::StaticOrder S; S.init(MTOT, 2 * DFF, VN(2), VB(2));
        pg8::EpiSwiglu E{ACT, DFF}; pg8::gemm_phase(lds, g, S, E, wv);
        { const int rem = ((MTOT / 256) * (2 * DFF / 256)) % nb;
          if (rem == 0 || (p.dup_mask & 4)) phase_transpose(p, lds, TR_SPLIT, TR_ALL, bid, nb, wv); else if (bid >= rem) phase_transpose(p, lds, TR_SPLIT, TR_ALL, bid - rem, nb - rem, wv); } }
    SEAM(2);
    if (IN(3)) { { pg8::Gemm g{ACT, (const bf16_t*)(ws + WS_W1D), MLAT, DM, DFF, DFF}; pg8::StaticOrder S; S.init(MLAT, DM, VN(3), VB(3));
          pg8::EpiResid E{p.in[0], p.in[2], X1, modp + 2 * DM, 0.5f}; pg8::gemm_phase(lds, g, S, E, wv); }
        { pg8::Gemm g{ACT, (const bf16_t*)(ws + WS_W1D), MTOT, DM, pg8::KSPLIT, DFF}; pg8::SplitOrder S; S.init(VN(3), VB(3));
          pg8::EpiPartial E{p.out + PART_OFF}; pg8::gemm_phase(lds, g, S, E, wv); } }
    SEAM(3);
    if (IN(4)) { phase_norm<true>(p, X1, p.in[2], MTOT, p.in[6] + DM, 3, HA, VB(4), VN(4), wv); }
    SEAM(4);
    if (IN(5)) { pg8::Gemm g{HA, (const bf16_t*)(ws + WS_WIN), MTOT, INW, DM, DM}; pg8::StaticOrder S; S.init(MTOT, INW, VN(5), VB(5));
        pg8::EpiBf16 E{(bf16_t*)(ws + WS_P), INW}; pg8::gemm_phase(lds, g, S, E, wv); }
    SEAM(5);
    if (IN(6)) { phase_prep_qkv(p, VB(6), VN(6), wv); phase_prep_hyena(p, lds, VB2(6, 18), VN2(6, 18), wv); }
    SEAM(6);
    if (IN(7)) { phase_attention(p, lds_g, VB(7), VN(7), wv); phase_hyena_conv(p, lds, VB2(7, 13), VN2(7, 13), wv); }
    SEAM(7);
    if (IN(8)) { phase_merge(p, lds, VB(8), VN(8), wv); }
    SEAM(8);
    if (IN(9)) { pg8::Gemm g{HA, (const bf16_t*)(ws + WS_WOUT), MLAT, DM, DM, DM}; pg8::StaticOrder S; S.init(MLAT, DM, VN(9), VB(9));
        pg8::EpiResid E{X1, X1, X1, modp + 5 * DM, 1.0f}; pg8::gemm_phase(lds, g, S, E, wv); }
    SEAM(9);
    if (IN(10)) { phase_norm<false>(p, X1, X1, MLAT, p.in[6] + 2 * DM, 6, HA, VB(10), VN(10), wv); }
    SEAM(10);
    if (IN(11)) { pg8::Gemm g{HA, (const bf16_t*)(ws + WS_W2U), MLAT, 2 * DFF, DM, DM}; pg8::StaticOrder S; S.init(MLAT, 2 * DFF, VN(11), VB(11));
        pg8::EpiSwiglu E{ACT, DFF}; pg8::gemm_phase(lds, g, S, E, wv); }
    SEAM(11);
    if (IN(12)) { pg8::Gemm g{ACT, (const bf16_t*)(ws + WS_W2D), MLAT, DM, DFF, DFF}; pg8::StaticOrder S; S.init(MLAT, DM, VN(12), VB(12));
        pg8::EpiResid E{X1, X1, p.out, modp + 8 * DM, 0.5f}; pg8::gemm_phase(lds, g, S, E, wv); }
#undef IN
#undef SEAM
}

extern "C" void kernel_launch(void* const* d_in, const int* in_sizes, int n_in, void* d_out, int out_size, void* d_ws, size_t ws_size, hipStream_t stream) {
    static int grid = 0;
    if (grid == 0) {
        if (n_in != 28 || out_size != MLAT * DM || ws_size < WS_END) { fprintf(stderr, "kernel_launch: unexpected shapes (n_in %d out %d ws %zu)\n", n_in, out_size, ws_size); grid = -1; return; }
        int dev = 0, cus = 0, per_cu = 0;
        hipGetDevice(&dev); hipDeviceGetAttribute(&cus, hipDeviceAttributeMultiprocessorCount, dev);
        if (hipFuncSetAttribute((const void*)mk_fwd, hipFuncAttributeMaxDynamicSharedMemorySize, LDS_BYTES) != hipSuccess) { fprintf(stderr, "kernel_launch: hipFuncSetAttribute failed\n"); grid = -1; return; }
        if (hipOccupancyMaxActiveBlocksPerMultiprocessor(&per_cu, (const void*)mk_fwd, NTHR, LDS_BYTES) != hipSuccess || per_cu < 1) { fprintf(stderr, "kernel_launch: occupancy query says %d\n", per_cu); per_cu = 1; }
        (void)hipGetLastError();
        grid = cus * 1;
    }
    if (grid < 0) return;
    Params p{};
    for (int i = 0; i < 28; ++i) p.in[i] = (const float*)d_in[i];
    p.out = (float*)d_out; p.ws = (unsigned char*)d_ws; p.dup_mask = DUP_MASK;
#if ONE_LAUNCH
    p.ph_lo = 0; p.ph_hi = NPHASE;
    void* args[] = {&p};
    if (hipMemsetAsync((char*)d_ws + WS_BAR, 0, XCD_BAR_WORDS * 4, stream) != hipSuccess) { fprintf(stderr, "kernel_launch: hipMemsetAsync of the barrier words failed\n"); return; }
    hipError_t e = hipLaunchCooperativeKernel((const void*)mk_fwd, dim3(grid), dim3(NTHR), args, LDS_BYTES, stream);
    if (e != hipSuccess) fprintf(stderr, "cooperative launch failed: %s (grid %d)\n", hipGetErrorString(e), grid);
#else
    for (int ph = 0; ph < NPHASE; ++ph) { p.ph_lo = ph; p.ph_hi = ph + 1;
        hipLaunchKernelGGL(mk_fwd, dim3(grid), dim3(NTHR), LDS_BYTES, stream, p); }
#endif
}
```

```cpp
#include <hip/hip_runtime.h>
#include <hip/hip_cooperative_groups.h>
#include <cstdio>
#include <cstdint>
namespace cg = cooperative_groups;

#define DUP_MASK 0
#ifndef ONE_LAUNCH
#define ONE_LAUNCH 1
#endif

#define LAS __attribute__((address_space(3)))
typedef unsigned short bf16_t;
typedef short bf16x8 __attribute__((ext_vector_type(8)));
typedef short s16x4 __attribute__((ext_vector_type(4)));
typedef float f32x2 __attribute__((ext_vector_type(2)));
typedef float f32x4 __attribute__((ext_vector_type(4)));
typedef float f32x16 __attribute__((ext_vector_type(16)));
typedef unsigned u32x2 __attribute__((ext_vector_type(2)));
typedef unsigned u32x4 __attribute__((ext_vector_type(4)));

constexpr int DM = 2048, NBATCH = 2, SEQ = 8192, CTXL = 256, HD = 128;
constexpr int MLAT = NBATCH * SEQ, MCTX = NBATCH * CTXL, MTOT = MLAT + MCTX;
constexpr int DFF = 5632, INW = 4608, NMODC = 9 * DM;
constexpr int HYW = 1024, ATW = 1024, NQH = 8, NKVH = 2;
constexpr int LKEYS = CTXL + SEQ;
constexpr int FFTN = 2 * SEQ;
constexpr float EPSN = 1e-6f;
constexpr int NTHR = 512;
constexpr int LDS_BYTES = 147456;

constexpr size_t MiB = 1u << 20;
constexpr size_t WS_MOD = 0, WS_PSUM = 1 * MiB;
constexpr size_t WS_W1U = 8 * MiB, WS_W1D = 52 * MiB, WS_WIN = 74 * MiB, WS_WOUT = 92 * MiB, WS_W2U = 100 * MiB, WS_W2D = 144 * MiB;
constexpr size_t WS_HA = 166 * MiB, WS_ACT = 232 * MiB, WS_X1 = 414 * MiB, WS_END = 546 * MiB;
constexpr size_t PART_OFF = (size_t)16 * MiB;
constexpr size_t WS_HF = WS_ACT;
constexpr size_t WS_P = WS_ACT;
constexpr size_t WS_Q = 8 * MiB, WS_K = 40 * MiB, WS_V = 49 * MiB;
constexpr size_t WS_VXT = WS_HA;
constexpr size_t WS_X0T = 381 * MiB;
constexpr size_t WS_HYOT = 232 * MiB;
constexpr size_t WS_ATTN = 296 * MiB;

struct Params { const float* in[28]; float* out; unsigned char* ws; int ph_lo, ph_hi; int dup_mask, pad; };

__device__ __forceinline__ unsigned cvt_pk_bf16(float lo, float hi) { unsigned r; asm volatile("v_cvt_pk_bf16_f32 %0, %1, %2" : "=v"(r) : "v"(lo), "v"(hi)); return r; }
__device__ __forceinline__ float bf_lo(unsigned w) { return __uint_as_float(w << 16); }
__device__ __forceinline__ float bf_hi(unsigned w) { return __uint_as_float(w & 0xffff0000u); }
__device__ __forceinline__ float bf2f(bf16_t b) { return __uint_as_float(((unsigned)b) << 16); }
__device__ __forceinline__ float wave_sum(float v) {
#pragma unroll
    for (int o = 1; o < 64; o <<= 1) v += __shfl_xor(v, o);
    return v;
}
#define LDS_WAIT() asm volatile("s_waitcnt lgkmcnt(0)" ::: "memory")
__device__ __forceinline__ int lane_id_asm() { int l; asm volatile("v_mbcnt_lo_u32_b32 %0, -1, 0\n\tv_mbcnt_hi_u32_b32 %0, -1, %0" : "=v"(l)); return l; }
#define TIDX(wv) (((wv) << 6) + lane_id_asm())

namespace pg8 {
constexpr int BM = 256, BK = 64, HALF = 128, HTB = HALF * BK * 2, STAGE_BYTES = 8 * HTB, NXCD = 8, WGM = 4;
__device__ __forceinline__ int lds_byte(int r, int c) { const int st = (r >> 4) * 2 + (c >> 5), rr = r & 15, cc = c & 31, ob = rr * 64 + cc * 2; return st * 1024 + (ob ^ (((ob >> 9) & 1) << 5)); }
__device__ __forceinline__ void stage_rc(int b, int& R, int& C) { const int st = b / 1024, sb = b % 1024, swz = sb ^ (((sb >> 9) & 1) << 5); R = (st >> 1) * 16 + swz / 64; C = (st & 1) * 32 + (swz % 64) / 2; }
__device__ __forceinline__ int perm32(int rho) { const int n = rho >> 4, i = rho & 15; return 8 * (i >> 2) + 4 * n + (i & 3); }
struct Unit { int pm, pn, k0; };
struct Gemm { const bf16_t* A; const bf16_t* Bt; int M, N, K, ldk; };
struct StaticOrder {
    int nM, nN, nwg, G, c;
    __device__ void init(int M, int N, int G_, int c_) { nM = M / BM; nN = N / BM; nwg = nM * nN; G = G_; c = c_; }
    __device__ bool next(int i, Unit& u) const {
        const long L = (long)i * G + c; if (L >= nwg) return false;
        int wgid = (int)L; { const int q = nwg / NXCD, r = nwg % NXCD, xcd = wgid % NXCD, off = wgid / NXCD; wgid = (xcd < r ? xcd * (q + 1) : r * (q + 1) + (xcd - r) * q) + off; }
        const int nig = WGM * nN, gid = wgid / nig, fm = gid * WGM, gsz = (nM - fm) < WGM ? (nM - fm) : WGM;
        u.pm = fm + ((wgid % nig) % gsz); u.pn = (wgid % nig) / gsz; u.k0 = 0; return true;
    }
};

constexpr int NSPLIT = 11, KSPLIT = DFF / NSPLIT;
struct SplitOrder {
    int G, c;
    __device__ void init(int G_, int c_) { G = G_; c = c_; }
    __device__ bool next(int i, Unit& u) const {
        const int L = i * G + c; if (L >= 16 * NSPLIT) return false;
        const int ks = L % NSPLIT, tl = L / NSPLIT;
        u.k0 = ks * KSPLIT; u.pn = tl & 7; u.pm = 64 + (tl >> 3); return true;
    }
};
struct EpiBf16 {
    static constexpr bool PERM = true;
    bf16_t* O; int ldc;
    __device__ __forceinline__ void operator()(const f32x4 (&acc)[2][2][4][2], const Unit& u, int wr, int wc, int fr, int fq) const {
        const int row0 = u.pm * BM + wr * 64 + fr, col0 = u.pn * BM + wc * 32 + 8 * fq;
#pragma unroll
        for (int ai = 0; ai < 2; ++ai)
#pragma unroll
            for (int m = 0; m < 4; ++m) { bf16_t* rowp = O + (size_t)(row0 + ai * HALF + m * 16) * ldc + col0;
#pragma unroll
                for (int bj = 0; bj < 2; ++bj) { const f32x4 v0 = acc[ai][bj][m][0], v1 = acc[ai][bj][m][1];
                    u32x4 w; w.x = cvt_pk_bf16(v0[0], v0[1]); w.y = cvt_pk_bf16(v0[2], v0[3]); w.z = cvt_pk_bf16(v1[0], v1[1]); w.w = cvt_pk_bf16(v1[2], v1[3]);
                    *(u32x4*)(rowp + bj * HALF) = w; } }
    }
};
__device__ __forceinline__ float silu_mul(float g, float u) { return g * u * __builtin_amdgcn_rcpf(1.0f + __builtin_amdgcn_exp2f(-1.4426950408889634f * g)); }
struct EpiSwiglu {
    static constexpr bool PERM = true;
    bf16_t* O; int ldc;
    __device__ __forceinline__ void operator()(const f32x4 (&acc)[2][2][4][2], const Unit& u, int wr, int wc, int fr, int fq) const {
        const int row0 = u.pm * BM + wr * 64 + fr, col0 = u.pn * HALF + wc * 32 + 8 * fq;
#pragma unroll
        for (int ai = 0; ai < 2; ++ai)
#pragma unroll
            for (int m = 0; m < 4; ++m) { bf16_t* rowp = O + (size_t)(row0 + ai * HALF + m * 16) * ldc + col0;
                const f32x4 g0 = acc[ai][0][m][0], g1 = acc[ai][0][m][1], u0 = acc[ai][1][m][0], u1 = acc[ai][1][m][1];
                u32x4 w;
                w.x = cvt_pk_bf16(silu_mul(g0[0], u0[0]), silu_mul(g0[1], u0[1])); w.y = cvt_pk_bf16(silu_mul(g0[2], u0[2]), silu_mul(g0[3], u0[3]));
                w.z = cvt_pk_bf16(silu_mul(g1[0], u1[0]), silu_mul(g1[1], u1[1])); w.w = cvt_pk_bf16(silu_mul(g1[2], u1[2]), silu_mul(g1[3], u1[3]));
                *(u32x4*)rowp = w; }
    }
};
struct EpiResid {
    static constexpr bool PERM = false;
    const float* base_lat; const float* base_ctx; float* out; const float* gate0; float gscale;
    __device__ __forceinline__ void operator()(const f32x4 (&acc)[2][2][4][2], const Unit& u, int wr, int wc, int fr, int fq) const {
        const int mi = u.pm < 32 ? 0 : (u.pm < 64 ? 1 : 2);
        const float* gate = gate0 + (size_t)mi * NMODC;
        const int row0 = u.pm * BM + wr * 64 + fr, col0 = u.pn * BM + wc * 32 + 4 * fq;
        f32x4 gv[2][2];
#pragma unroll
        for (int bj = 0; bj < 2; ++bj)
#pragma unroll
            for (int n = 0; n < 2; ++n) gv[bj][n] = *(const f32x4*)(gate + col0 + bj * HALF + n * 16) * gscale;
#pragma unroll
        for (int ai = 0; ai < 2; ++ai)
#pragma unroll
            for (int m = 0; m < 4; ++m) { const size_t off = (size_t)(row0 + ai * HALF + m * 16) * DM + col0;
                const float* bp = (u.pm < 64) ? (base_lat + off) : (base_ctx + (off - (size_t)MLAT * DM));
#pragma unroll
                for (int bj = 0; bj < 2; ++bj)
#pragma unroll
                    for (int n = 0; n < 2; ++n) { const f32x4 bs = *(const f32x4*)(bp + bj * HALF + n * 16);
                        *(f32x4*)(out + off + bj * HALF + n * 16) = bs + gv[bj][n] * acc[ai][bj][m][n]; }
                if (m == 3) asm volatile("" ::: "memory"); }
    }
};

struct EpiPartial {
    static constexpr bool PERM = false;
    float* part;
    __device__ __forceinline__ void operator()(const f32x4 (&acc)[2][2][4][2], const Unit& u, int wr, int wc, int fr, int fq) const {
        const int ks = u.k0 / KSPLIT;
        float* base = part + (size_t)ks * MCTX * DM;
        const int row0 = (u.pm - 64) * BM + wr * 64 + fr, col0 = u.pn * BM + wc * 32 + 4 * fq;
#pragma unroll
        for (int ai = 0; ai < 2; ++ai)
#pragma unroll
            for (int m = 0; m < 4; ++m) { float* rp = base + (size_t)(row0 + ai * HALF + m * 16) * DM + col0;
#pragma unroll
                for (int bj = 0; bj < 2; ++bj)
#pragma unroll
                    for (int n = 0; n < 2; ++n) *(f32x4*)(rp + bj * HALF + n * 16) = acc[ai][bj][m][n]; }
    }
};

template <class Epi, class Sched, bool ALIGN_EPI = true, bool SP2 = true>
__device__ __forceinline__ void gemm_phase(LAS unsigned char* lds, const Gemm g, const Sched& S, const Epi& E, int wv) {
    const int tid = TIDX(wv), wid = wv, lane = tid & 63, wr = wid >> 2, wc = wid & 3, fr = lane & 15, fq = lane >> 4;
    const int K = g.ldk, nt = g.K / BK;
    unsigned voffA[2], voffB[2];
#pragma unroll
    for (int i = 0; i < 2; ++i) { int R, C; stage_rc(tid * 16 + i * 8192, R, C); const int Rb = Epi::PERM ? ((R & ~31) + perm32(R & 31)) : R;
        voffA[i] = (unsigned)(R * K + C) * 2u; voffB[i] = (unsigned)(Rb * K + C) * 2u; }
    const size_t kstep = (size_t)(BK * 2);
    const size_t hstep = (size_t)HALF * K * 2;
    const size_t tstep = 2 * hstep;
    const unsigned ldsw = (unsigned)wid * 1024u;
    const int aoff = lds_byte(wr * 64 + fr, fq * 8), boff = lds_byte(wc * 32 + fr, fq * 8);
#define PG8_SA(b, h) (((b) * 2 + (h)) * HTB)
#define PG8_SB(b, h) ((4 + (b) * 2 + (h)) * HTB)
#define PG8_STAGE(bufoff, gbase, voff) do { _Pragma("unroll") for (int _i = 0; _i < 2; ++_i) \
        __builtin_amdgcn_global_load_lds((const unsigned*)((const char*)(gbase) + (voff)[_i]), (LAS unsigned*)(lds + (bufoff) + ldsw + _i * 8192), 16, 0, 0); } while (0)
#define PG8_LDA(dst, b, h) do { _Pragma("unroll") for (int m = 0; m < 4; ++m) _Pragma("unroll") for (int k = 0; k < 2; ++k) dst[m][k] = *(const LAS bf16x8*)(lds + PG8_SA(b, h) + aoff + m * 2048 + k * 1024); } while (0)
#define PG8_LDB(dst, b, h) do { _Pragma("unroll") for (int n = 0; n < 2; ++n) _Pragma("unroll") for (int k = 0; k < 2; ++k) dst[n][k] = *(const LAS bf16x8*)(lds + PG8_SB(b, h) + boff + n * 2048 + k * 1024); } while (0)
#define PG8_MMA(ai, bj, At, Bt) do { __builtin_amdgcn_s_setprio(1); _Pragma("unroll") for (int m = 0; m < 4; ++m) _Pragma("unroll") for (int n = 0; n < 2; ++n) _Pragma("unroll") for (int k = 0; k < 2; ++k) \
        acc[ai][bj][m][n] = __builtin_amdgcn_mfma_f32_16x16x32_bf16(Bt[n][k], At[m][k], acc[ai][bj][m][n], 0, 0, 0); __builtin_amdgcn_s_setprio(0); } while (0)
#define PG8_WAIT_V(n) asm volatile("s_waitcnt vmcnt(" #n ")" ::: "memory")
#define PG8_WAIT_L(n) asm volatile("s_waitcnt lgkmcnt(" #n ")" ::: "memory")
#define PG8_BAR __builtin_amdgcn_s_barrier()
#define PG8_SCHED __builtin_amdgcn_sched_barrier(0)
    Unit cur, nxt; int ui = 0;
    if (!S.next(0, cur)) return;
    f32x4 acc[2][2][4][2];
#pragma unroll
    for (int a = 0; a < 2; ++a)
#pragma unroll
        for (int b = 0; b < 2; ++b)
#pragma unroll
            for (int m = 0; m < 4; ++m)
#pragma unroll
                for (int n = 0; n < 2; ++n) acc[a][b][m][n] = (f32x4){0.f, 0.f, 0.f, 0.f};
    bf16x8 At[4][2], B0[2][2], B1[2][2];
    const char* cA = (const char*)g.A + (size_t)cur.pm * tstep + (size_t)cur.k0 * 2; const char* cB = (const char*)g.Bt + (size_t)cur.pn * tstep + (size_t)cur.k0 * 2;
    if constexpr (SP2) {
        PG8_STAGE(PG8_SB(0, 0), cB, voffB); PG8_STAGE(PG8_SB(0, 1), cB + hstep, voffB); PG8_STAGE(PG8_SA(0, 0), cA, voffA); PG8_STAGE(PG8_SA(0, 1), cA + hstep, voffA);
        if (wr == 1) PG8_BAR;
        PG8_WAIT_V(2); PG8_BAR;
        PG8_STAGE(PG8_SB(1, 0), cB + kstep, voffB); PG8_STAGE(PG8_SA(1, 0), cA + kstep, voffA); PG8_STAGE(PG8_SB(1, 1), cB + hstep + kstep, voffB);
        PG8_WAIT_V(6); PG8_BAR;
    } else {
        PG8_STAGE(PG8_SB(0, 0), cB, voffB); PG8_STAGE(PG8_SA(0, 0), cA, voffA); PG8_STAGE(PG8_SB(0, 1), cB + hstep, voffB); PG8_STAGE(PG8_SA(0, 1), cA + hstep, voffA);
        if (wr == 1) PG8_BAR;
        PG8_WAIT_V(4); PG8_BAR;
        PG8_STAGE(PG8_SB(1, 0), cB + kstep, voffB); PG8_STAGE(PG8_SA(1, 0), cA + kstep, voffA); PG8_STAGE(PG8_SB(1, 1), cB + hstep + kstep, voffB);
        PG8_WAIT_V(6); PG8_BAR;
    }
    for (;;) {
        const bool has_next = S.next(ui + 1, nxt);
        const char* nA = has_next ? (const char*)g.A + (size_t)nxt.pm * tstep + (size_t)nxt.k0 * 2 : cA; const char* nB = has_next ? (const char*)g.Bt + (size_t)nxt.pn * tstep + (size_t)nxt.k0 * 2 : cB;
        for (int t = 0; t < nt; t += 2) {
            const bool last = (t == nt - 2);
            const char* a1 = cA + (size_t)(t + 1) * kstep;
            const char* a2 = last ? nA : cA + (size_t)(t + 2) * kstep; const char* b2 = last ? nB : cB + (size_t)(t + 2) * kstep;
            const char* a3 = a2 + kstep; const char* b3 = b2 + kstep;
            if constexpr (SP2) {
            PG8_LDB(B0, 0, 0); PG8_LDB(B1, 0, 1); PG8_SCHED; PG8_LDA(At, 0, 0); PG8_STAGE(PG8_SA(1, 1), a1 + hstep, voffA);
            PG8_WAIT_V(8); PG8_WAIT_L(0); PG8_BAR; PG8_MMA(0, 0, At, B0); PG8_MMA(0, 1, At, B1); PG8_BAR; PG8_SCHED;
            PG8_LDA(At, 0, 1); PG8_STAGE(PG8_SB(0, 0), b2, voffB); PG8_STAGE(PG8_SB(0, 1), b2 + hstep, voffB); PG8_STAGE(PG8_SA(0, 0), a2, voffA);
            PG8_WAIT_V(8); PG8_WAIT_L(0); PG8_BAR; PG8_MMA(1, 0, At, B0); PG8_MMA(1, 1, At, B1); PG8_BAR; PG8_SCHED;
            PG8_LDB(B0, 1, 0); PG8_LDB(B1, 1, 1); PG8_SCHED; PG8_LDA(At, 1, 0); PG8_STAGE(PG8_SA(0, 1), a2 + hstep, voffA);
            PG8_WAIT_V(8); PG8_WAIT_L(0); PG8_BAR; PG8_MMA(0, 0, At, B0); PG8_MMA(0, 1, At, B1); PG8_BAR; PG8_SCHED;
            PG8_LDA(At, 1, 1); PG8_STAGE(PG8_SB(1, 0), b3, voffB); PG8_STAGE(PG8_SB(1, 1), b3 + hstep, voffB); PG8_STAGE(PG8_SA(1, 0), a3, voffA);
            PG8_WAIT_V(8); PG8_WAIT_L(0); PG8_BAR; PG8_MMA(1, 0, At, B0); PG8_MMA(1, 1, At, B1); PG8_BAR; PG8_SCHED;
            } else {
            PG8_LDB(B0, 0, 0); PG8_SCHED; PG8_LDA(At, 0, 0); PG8_STAGE(PG8_SA(1, 1), a1 + hstep, voffA);
            PG8_WAIT_L(8); PG8_BAR; PG8_WAIT_L(0); PG8_MMA(0, 0, At, B0); PG8_BAR; PG8_SCHED;
            PG8_LDB(B1, 0, 1); PG8_STAGE(PG8_SB(0, 0), b2, voffB);
            PG8_BAR; PG8_WAIT_L(0); PG8_MMA(0, 1, At, B1); PG8_BAR;
            PG8_LDA(At, 0, 1); PG8_STAGE(PG8_SA(0, 0), a2, voffA);
            PG8_BAR; PG8_WAIT_L(0); PG8_MMA(1, 0, At, B0); PG8_BAR; PG8_SCHED;
            PG8_STAGE(PG8_SB(0, 1), b2 + hstep, voffB);
            PG8_WAIT_V(6); PG8_BAR; PG8_MMA(1, 1, At, B1); PG8_BAR;
            PG8_LDB(B0, 1, 0); PG8_SCHED; PG8_LDA(At, 1, 0); PG8_STAGE(PG8_SA(0, 1), a2 + hstep, voffA);
            PG8_WAIT_L(8); PG8_BAR; PG8_WAIT_L(0); PG8_MMA(0, 0, At, B0); PG8_BAR; PG8_SCHED;
            PG8_LDB(B1, 1, 1); PG8_STAGE(PG8_SB(1, 0), b3, voffB);
            PG8_BAR; PG8_WAIT_L(0); PG8_MMA(0, 1, At, B1); PG8_BAR;
            PG8_LDA(At, 1, 1); PG8_STAGE(PG8_SA(1, 0), a3, voffA);
            PG8_BAR; PG8_WAIT_L(0); PG8_MMA(1, 0, At, B0); PG8_BAR; PG8_SCHED;
            PG8_STAGE(PG8_SB(1, 1), b3 + hstep, voffB);
            PG8_WAIT_V(6); PG8_BAR; PG8_MMA(1, 1, At, B1); PG8_BAR;
            }
        }
        if constexpr (ALIGN_EPI) { if (wr == 0) PG8_BAR; }
        E(acc, cur, wr, wc, fr, fq);
        if (!has_next) break;
#pragma unroll
        for (int a = 0; a < 2; ++a)
#pragma unroll
            for (int b = 0; b < 2; ++b)
#pragma unroll
                for (int m = 0; m < 4; ++m)
#pragma unroll
                    for (int n = 0; n < 2; ++n) acc[a][b][m][n] = (f32x4){0.f, 0.f, 0.f, 0.f};
        cur = nxt; cA = nA; cB = nB; ++ui;
        if constexpr (ALIGN_EPI) { if (wr == 1) PG8_BAR; }
    }
    PG8_WAIT_V(0);
    if constexpr (!ALIGN_EPI) { if (wr == 0) PG8_BAR; }
    PG8_BAR;
#undef PG8_SA
#undef PG8_SB
#undef PG8_STAGE
#undef PG8_LDA
#undef PG8_LDB
#undef PG8_MMA
#undef PG8_WAIT_V
#undef PG8_WAIT_L
#undef PG8_BAR
#undef PG8_SCHED
}
}

namespace att {
constexpr int D = 128, NW = 8, QBLK = 32, KVBLK = 64;
constexpr float SCALE = 0.088388347648318440f;
constexpr float THR = 8.f;
#ifndef ATT_SDEPTH
#define ATT_SDEPTH 1
#endif
constexpr int LDQ = 128, LDK = 128, LDO = ATW;
constexpr size_t SHM_V = KVBLK * D * 2, SHM_K = KVBLK * D * 2, SHM_ATTN = 2 * SHM_V + 2 * SHM_K + NW * 64 * 4;
#define KSWZ(row, colB) ((row) * 256 + ((colB) ^ (((row) & 7) << 4)))
#define SBAR() __builtin_amdgcn_sched_barrier(0)
__device__ __forceinline__ int crow(int r, int hi) { return (r & 3) + 8 * (r >> 2) + 4 * hi; }
__device__ __forceinline__ unsigned cvtpk(float lo, float hi) { unsigned r; asm volatile("v_cvt_pk_bf16_f32 %0, %1, %2" : "=v"(r) : "v"(lo), "v"(hi)); return r; }
__device__ __forceinline__ void partialSM(f32x16& p0, f32x16& p1, float& m_reg, float& mn, float& alpha) {
  constexpr float C = SCALE * 1.4426950408889634f;
  float pmax = p0[0]; for (int r = 1; r < 16; ++r) pmax = fmaxf(pmax, p0[r]); for (int r = 0; r < 16; ++r) pmax = fmaxf(pmax, p1[r]);
  { auto rr = __builtin_amdgcn_permlane32_swap(__float_as_uint(pmax), __float_as_uint(pmax), false, false);
    pmax = fmaxf(__uint_as_float(rr[0]), __uint_as_float(rr[1])); }
  if (__builtin_expect(__all(pmax - m_reg <= THR / SCALE), 1)) { mn = m_reg; alpha = 1.f; }
  else { mn = fmaxf(m_reg, pmax); alpha = __builtin_amdgcn_exp2f((m_reg - mn) * C); m_reg = mn; }
  float mnC = -mn * C;
  for (int r = 0; r < 16; ++r) p0[r] = fmaf(p0[r], C, mnC); for (int r = 0; r < 16; ++r) p1[r] = fmaf(p1[r], C, mnC);
  for (int r = 0; r < 16; ++r) p0[r] = __builtin_amdgcn_exp2f(p0[r]);
}
__device__ __forceinline__ void finishSM(f32x16& p0, f32x16& p1, float alpha, float& l_reg, bf16x8& pa0, bf16x8& pa1, bf16x8& pa2, bf16x8& pa3) {
  for (int r = 0; r < 16; ++r) p1[r] = __builtin_amdgcn_exp2f(p1[r]);
  float ps = 0; for (int r = 0; r < 16; ++r) ps += p0[r]; for (int r = 0; r < 16; ++r) ps += p1[r];
  { auto rr = __builtin_amdgcn_permlane32_swap(__float_as_uint(ps), __float_as_uint(ps), false, false);
    ps = __uint_as_float(rr[0]) + __uint_as_float(rr[1]); }
  l_reg = l_reg * alpha + ps;
#define PK4(P, BASE, OUT) do { unsigned a0 = cvtpk(P[BASE + 0], P[BASE + 1]), a1 = cvtpk(P[BASE + 2], P[BASE + 3]);   \
    unsigned b0 = cvtpk(P[BASE + 4], P[BASE + 5]), b1 = cvtpk(P[BASE + 6], P[BASE + 7]);                              \
    auto r0 = __builtin_amdgcn_permlane32_swap(a0, b0, false, false); auto r1 = __builtin_amdgcn_permlane32_swap(a1, b1, false, false); \
    u32x4 w = {r0[0], r1[0], r0[1], r1[1]}; OUT = *reinterpret_cast<bf16x8*>(&w); } while (0)
  PK4(p0, 0, pa0); PK4(p0, 8, pa1); PK4(p1, 0, pa2); PK4(p1, 8, pa3);
#undef PK4
}
__device__ __forceinline__ void qkt(f32x16& p0, f32x16& p1, const bf16_t* Ks, const bf16x8* qr, int r32, int hi) {
  p0 = f32x16{}; p1 = f32x16{};
  for (int d0 = 0; d0 < 8; ++d0) { int cb = (d0 * 16 + hi * 8) * 2;
    bf16x8 b0 = *reinterpret_cast<const bf16x8*>((const char*)Ks + KSWZ(r32, cb));
    bf16x8 b1 = *reinterpret_cast<const bf16x8*>((const char*)Ks + KSWZ(32 + r32, cb));
    p0 = __builtin_amdgcn_mfma_f32_32x32x16_bf16(b0, qr[d0], p0, 0, 0, 0);
    p1 = __builtin_amdgcn_mfma_f32_32x32x16_bf16(b1, qr[d0], p1, 0, 0, 0); }
}
__device__ __forceinline__ int v_st(int k, int c) { const int kk = (k & ~0xC) | ((k & 4) << 1) | ((k & 8) >> 1); return ((kk >> 3) * 4 + (c >> 5)) * 512 + ((kk & 7) * 32 + (c & 31)) * 2; }
__device__ __forceinline__ int v_rd_base(int lane) { return ((lane & 3) << 3) | (((lane >> 2) & 3) << 6) | (((lane >> 4) & 1) << 5) | (((lane >> 5) & 1) << 8); }
constexpr int v_rd_off(int d0, int ks, int half) { return d0 * 512 + ks * 4096 + half * 2048; }
template <int OFF> __device__ __forceinline__ s16x4 tr_read(int vb) {
  s16x4 r; asm volatile("ds_read_b64_tr_b16 %0, %1 offset:%2" : "=&v"(r) : "v"(vb), "i"(OFF) : "memory"); return r;
}
template <int D0> __device__ __forceinline__ void pv_one(f32x16& od, int vb, bf16x8 pa0, bf16x8 pa1, bf16x8 pa2, bf16x8 pa3) {
  const s16x4 l0 = tr_read<v_rd_off(D0, 0, 0)>(vb), h0 = tr_read<v_rd_off(D0, 0, 1)>(vb), l1 = tr_read<v_rd_off(D0, 1, 0)>(vb), h1 = tr_read<v_rd_off(D0, 1, 1)>(vb);
  const s16x4 l2 = tr_read<v_rd_off(D0, 2, 0)>(vb), h2 = tr_read<v_rd_off(D0, 2, 1)>(vb), l3 = tr_read<v_rd_off(D0, 3, 0)>(vb), h3 = tr_read<v_rd_off(D0, 3, 1)>(vb);
  asm volatile("s_waitcnt lgkmcnt(0)" ::: "memory"); SBAR();
#define PK(L, H) (bf16x8){L[0], L[1], L[2], L[3], H[0], H[1], H[2], H[3]}
  od = __builtin_amdgcn_mfma_f32_32x32x16_bf16(pa0, PK(l0, h0), od, 0, 0, 0);
  od = __builtin_amdgcn_mfma_f32_32x32x16_bf16(pa1, PK(l1, h1), od, 0, 0, 0);
  od = __builtin_amdgcn_mfma_f32_32x32x16_bf16(pa2, PK(l2, h2), od, 0, 0, 0);
  od = __builtin_amdgcn_mfma_f32_32x32x16_bf16(pa3, PK(l3, h3), od, 0, 0, 0);
#undef PK
}
__device__ __forceinline__ void pv_d0(f32x16* o, int vb, bf16x8 pa0, bf16x8 pa1, bf16x8 pa2, bf16x8 pa3) {
  pv_one<0>(o[0], vb, pa0, pa1, pa2, pa3); pv_one<1>(o[1], vb, pa0, pa1, pa2, pa3); pv_one<2>(o[2], vb, pa0, pa1, pa2, pa3); pv_one<3>(o[3], vb, pa0, pa1, pa2, pa3);
}
__device__ __forceinline__ void attn_dense_body(const bf16_t* __restrict__ Qb, const bf16_t* __restrict__ Kh, const bf16_t* __restrict__ Vh,
                                                float* __restrict__ Ob, int seq, char* lds, int wv) {
  const int tid = TIDX(wv), wid = tid >> 6, lane = tid & 63, r32 = lane & 31, hi = lane >> 5;
  bf16_t* V_lds = (bf16_t*)lds; bf16_t* K_lds = (bf16_t*)(lds + 2 * SHM_V);
  float* ws = (float*)(lds + 2 * SHM_V + 2 * SHM_K) + wid * 64; float* li_l = ws; float* al_l = ws + 32;
  float m_reg = -1e30f, l_reg = 0; f32x16 o[4] = {}; bf16x8 qr[8];
  const bf16_t* Qw = Qb + (long)(wid * QBLK + r32) * LDQ + hi * 8;
#pragma unroll
  for (int d0 = 0; d0 < 8; ++d0) qr[d0] = *reinterpret_cast<const bf16x8*>(Qw + d0 * 16);
  const int sr = tid >> 4, sc = (tid & 15) * 8, vst0 = v_st(sr, sc), vst1 = v_st(32 + sr, sc);
  const int vb0 = (int)(uintptr_t)V_lds + v_rd_base(lane);
  constexpr int SDEPTH = ATT_SDEPTH;
  struct { bf16x8 vs0, vs1, ks0, ks1; } sr_[SDEPTH];
#define SLOAD(i, k0) do { sr_[i].vs0 = *reinterpret_cast<const bf16x8*>(&Vh[(long)((k0) + sr) * LDK + sc]); sr_[i].vs1 = *reinterpret_cast<const bf16x8*>(&Vh[(long)((k0) + 32 + sr) * LDK + sc]); \
    sr_[i].ks0 = *reinterpret_cast<const bf16x8*>(&Kh[(long)((k0) + sr) * LDK + sc]); sr_[i].ks1 = *reinterpret_cast<const bf16x8*>(&Kh[(long)((k0) + 32 + sr) * LDK + sc]); } while (0)
#define SWRITE(b, i) do { *(bf16x8*)((char*)V_lds + (b) * SHM_V + vst0) = sr_[i].vs0;          \
    *(bf16x8*)((char*)V_lds + (b) * SHM_V + vst1) = sr_[i].vs1; int kc = sc * 2;               \
    *(bf16x8*)((char*)K_lds + (b) * SHM_K + KSWZ(sr, kc)) = sr_[i].ks0;                       \
    *(bf16x8*)((char*)K_lds + (b) * SHM_K + KSWZ(32 + sr, kc)) = sr_[i].ks1; } while (0)
#define SWAIT() do { if (SDEPTH == 2) asm volatile("s_waitcnt vmcnt(4)" ::: "memory"); else asm volatile("s_waitcnt vmcnt(0)" ::: "memory"); } while (0)
#define RESC(a) do { if (__any((a) < 1.f)) { if (hi == 0) al_l[r32] = (a); asm volatile("s_waitcnt lgkmcnt(0)" ::: "memory"); \
    for (int d = 0; d < 4; ++d) for (int r = 0; r < 16; ++r) o[d][r] *= al_l[crow(r, hi)]; } } while (0)
  f32x16 pA0, pA1, pB0, pB1; float mnA, mnB, alA, alB; bf16x8 pa0, pa1, pa2, pa3; const int NT = seq / KVBLK;
  if (wv >= 4) __builtin_amdgcn_s_setprio(1);
  constexpr int SE = 0, SO = SDEPTH - 1;
  SLOAD(SE, 0); asm volatile("s_waitcnt vmcnt(0)" ::: "memory"); SWRITE(0, SE); __syncthreads();
  qkt(pA0, pA1, K_lds, qr, r32, hi); partialSM(pA0, pA1, m_reg, mnA, alA);
  SLOAD(SO, KVBLK); if (SDEPTH == 2) { if (2 < NT) SLOAD(SE, 2 * KVBLK); }
  SWAIT(); SWRITE(1, SO); __syncthreads();
  for (int j = 1; j + 1 < NT; j += 2) {
    SBAR(); qkt(pB0, pB1, (bf16_t*)((char*)K_lds + SHM_K), qr, r32, hi);
    finishSM(pA0, pA1, alA, l_reg, pa0, pa1, pa2, pa3); SBAR();
    SLOAD(SO, (j + SDEPTH) * KVBLK); SBAR();
    pv_d0(o, vb0, pa0, pa1, pa2, pa3); partialSM(pB0, pB1, m_reg, mnB, alB);
    __syncthreads(); SWAIT(); SWRITE(0, SE);
    RESC(alB); __syncthreads();
    SBAR(); qkt(pA0, pA1, K_lds, qr, r32, hi);
    finishSM(pB0, pB1, alB, l_reg, pa0, pa1, pa2, pa3); SBAR();
    if (SDEPTH == 1 || j + 3 < NT) SLOAD(SE, (j + 1 + SDEPTH) * KVBLK); SBAR();
    pv_d0(o, vb0 + (int)SHM_V, pa0, pa1, pa2, pa3); partialSM(pA0, pA1, m_reg, mnA, alA);
    __syncthreads(); SWAIT(); SWRITE(1, SO);
    RESC(alA); __syncthreads();
  }
  SBAR(); qkt(pB0, pB1, (bf16_t*)((char*)K_lds + SHM_K), qr, r32, hi);
  finishSM(pA0, pA1, alA, l_reg, pa0, pa1, pa2, pa3); SBAR();
  pv_d0(o, vb0, pa0, pa1, pa2, pa3); partialSM(pB0, pB1, m_reg, mnB, alB);
  __syncthreads(); RESC(alB);
  finishSM(pB0, pB1, alB, l_reg, pa0, pa1, pa2, pa3); SBAR();
  pv_d0(o, vb0 + (int)SHM_V, pa0, pa1, pa2, pa3);
  if (wv >= 4) __builtin_amdgcn_s_setprio(0);
  if (hi == 0) li_l[r32] = l_reg; asm volatile("s_waitcnt lgkmcnt(0)" ::: "memory");
  float rli[16];
#pragma unroll
  for (int r = 0; r < 16; ++r) rli[r] = __builtin_amdgcn_rcpf(li_l[crow(r, hi)]);
  float* Ow = Ob + (long)(wid * QBLK) * LDO;
#pragma unroll
  for (int r = 0; r < 16; ++r) { int orow = crow(r, hi);
    for (int d0 = 0; d0 < 4; ++d0) Ow[(long)orow * LDO + d0 * 32 + r32] = o[d0][r] * rli[r]; }
#undef SLOAD
#undef SWRITE
#undef SWAIT
#undef RESC
}
}

struct TrItem { const float* W; bf16_t* WT; int K, N, k0, n0, drow0; };
__device__ __forceinline__ int up_row(int n0) { const int half = n0 / DFF, rem = n0 - half * DFF; return 256 * (rem >> 7) + 128 * half + (rem & 127); }
__device__ __forceinline__ TrItem tr_decode(const Params& p, int it) {
    constexpr int I_U = (DM / 64) * (2 * DFF / 64), I_D = (DFF / 64) * (DM / 64), I_IN = (DM / 64) * (INW / 64), I_O = (DM / 64) * (DM / 64);
    unsigned char* ws = p.ws; TrItem t; int r = it; int nblk; bool up = false;
    if (r < I_U) { t.W = p.in[7]; t.WT = (bf16_t*)(ws + WS_W1U); t.K = DM; t.N = 2 * DFF; up = true; }
    else if ((r -= I_U) < I_D) { t.W = p.in[8]; t.WT = (bf16_t*)(ws + WS_W1D); t.K = DFF; t.N = DM; }
    else if ((r -= I_D) < I_IN) { t.W = p.in[11]; t.WT = (bf16_t*)(ws + WS_WIN); t.K = DM; t.N = INW; }
    else if ((r -= I_IN) < I_O) { t.W = p.in[27]; t.WT = (bf16_t*)(ws + WS_WOUT); t.K = DM; t.N = DM; }
    else if ((r -= I_O) < I_U) { t.W = p.in[9]; t.WT = (bf16_t*)(ws + WS_W2U); t.K = DM; t.N = 2 * DFF; up = true; }
    else { r -= I_U; t.W = p.in[10]; t.WT = (bf16_t*)(ws + WS_W2D); t.K = DFF; t.N = DM; }
    nblk = t.N / 64; t.k0 = 64 * (r / nblk); t.n0 = 64 * (r % nblk); t.drow0 = up ? up_row(t.n0) : t.n0;
    return t;
}
__device__ __forceinline__ void phase_transpose(const Params& p, LAS unsigned char* lds, int it_beg, int it_end, int bid, int nb, int wv) {
    const int tid = TIDX(wv), wave = tid >> 6, lane = tid & 63;
    LAS float* scr = (LAS float*)(lds + wave * 16640);
    const int gw = it_beg + bid * 8 + wave, NGW = nb * 8; const int NITEMS = it_end;
    float R[64];
#define TR_LOAD(t_) do { const float* src_ = (t_).W + (size_t)(t_).k0 * (t_).N + (t_).n0 + lane; _Pragma("unroll") for (int i = 0; i < 64; ++i) R[i] = src_[(size_t)i * (t_).N]; } while (0)
    if (gw < NITEMS) { const TrItem t0 = tr_decode(p, gw); TR_LOAD(t0); }
    for (int it = gw; it < NITEMS; it += NGW) {
        const TrItem t = tr_decode(p, it);
#pragma unroll
        for (int i = 0; i < 64; ++i) scr[i * 65 + lane] = R[i];
        if (it + NGW < NITEMS) { const TrItem tn = tr_decode(p, it + NGW); TR_LOAD(tn); }
        LDS_WAIT();
#pragma unroll
        for (int j = 0; j < 8; ++j) { const int item = lane + 64 * j, kc = item & 7, n = item >> 3; const LAS float* s = scr + (8 * kc) * 65 + n;
            u32x4 o; o.x = cvt_pk_bf16(s[0 * 65], s[1 * 65]); o.y = cvt_pk_bf16(s[2 * 65], s[3 * 65]); o.z = cvt_pk_bf16(s[4 * 65], s[5 * 65]); o.w = cvt_pk_bf16(s[6 * 65], s[7 * 65]);
            *(u32x4*)(t.WT + (size_t)(t.drow0 + n) * t.K + t.k0 + 8 * kc) = o; }
        LDS_WAIT();
    }
#undef TR_LOAD
    __syncthreads();
}

__device__ __forceinline__ void phase_mod(const Params& p, LAS unsigned char* lds, int bid, int nb, int wv) {
    const int tid = TIDX(wv);
    LAS float* s = (LAS float*)lds;
    LAS float* red = (LAS float*)(lds + 3 * DM * 4);
    float* mod = (float*)(p.ws + WS_MOD);
    const float* wada = p.in[4]; const float* bada = p.in[5];
    for (int strip = bid; strip < NMODC / 72; strip += nb) {
        __syncthreads();
        for (int i = tid; i < 3 * DM; i += NTHR) { const int b = i / DM, k = i - b * DM; const float v = (b < 2) ? p.in[1][b * DM + k] : p.in[3][k]; s[i] = v / (1.0f + __expf(-v)); }
        __syncthreads();
        const int cgp = tid % 18, kl = tid / 18;
        if (kl < 28) {
            f32x4 a0 = {0.f, 0.f, 0.f, 0.f}, a1 = a0, a2 = a0;
            const float* wp = wada + (size_t)strip * 72 + 4 * cgp;
            int k = kl;
            for (; k + 28 * 7 < DM; k += 28 * 8) { f32x4 w[8];
#pragma unroll
                for (int q = 0; q < 8; ++q) w[q] = *(const f32x4*)(wp + (size_t)(k + 28 * q) * NMODC);
#pragma unroll
                for (int q = 0; q < 8; ++q) { a0 += w[q] * s[k + 28 * q]; a1 += w[q] * s[DM + k + 28 * q]; a2 += w[q] * s[2 * DM + k + 28 * q]; } }
            for (; k < DM; k += 28) { const f32x4 w = *(const f32x4*)(wp + (size_t)k * NMODC); a0 += w * s[k]; a1 += w * s[DM + k]; a2 += w * s[2 * DM + k]; }
            LAS float* rp = red + (kl * 18 + cgp) * 12;
#pragma unroll
            for (int i = 0; i < 4; ++i) { rp[i] = a0[i]; rp[4 + i] = a1[i]; rp[8 + i] = a2[i]; }
        }
        __syncthreads();
        if (tid < 216) { const int cg2 = tid / 12, r = tid % 12, b = r >> 2, i = r & 3; float sum = 0.f;
            for (int q = 0; q < 28; ++q) sum += red[(q * 18 + cg2) * 12 + r];
            const int col = strip * 72 + 4 * cg2 + i; mod[(size_t)b * NMODC + col] = sum + bada[col]; }
    }
    __syncthreads();
}

__device__ __forceinline__ void phase_filter(const Params& p, LAS unsigned char* lds, int bid, int nb, int wv) {
    const int tid = TIDX(wv), wave = tid >> 6, lane = tid & 63;
    if (bid >= SEQ / 32) return;
    LAS float* W1s = (LAS float*)lds;
    LAS float* W2s = W1s + 33 * 64;
    LAS float* W3s = W2s + 64 * 64;
    LAS float* B1s = W3s + 64 * 64; LAS float* B2s = B1s + 64; LAS float* B3s = B2s + 64; LAS float* FRs = B3s + 64;
    LAS float* zs = FRs + 64;
    LAS float* ha = zs + 32 * 33;
    LAS float* hb = ha + 32 * 65;
    LAS float* h3 = (LAS float*)(lds + 65536);
    for (int i = tid; i < 33 * 64; i += NTHR) W1s[i] = p.in[16][i];
    for (int i = tid; i < 64 * 64; i += NTHR) { W2s[i] = p.in[18][i]; W3s[i] = p.in[20][i]; }
    if (tid < 64) { B1s[tid] = p.in[17][tid]; B2s[tid] = p.in[19][tid]; B3s[tid] = p.in[21][tid]; FRs[tid] = p.in[23][tid]; }
    const float* w4 = p.in[22]; const float* decay = p.in[24];
    float* hf = (float*)(p.ws + WS_HF); float* psum = (float*)(p.ws + WS_PSUM);
    for (int tile = bid; tile < SEQ / 32; tile += nb) {
        const int t0 = tile * 32;
        __syncthreads();
        { const int t = tid & 31, b = tid >> 5; const int tg = t0 + t;
          const float w = 6.283185307179586f * (float)tg / (float)SEQ;
          const float f = 1e-4f + (float)b * ((15.0f - 1e-4f) / 15.0f);
          float sn, cs; sincosf(f * w, &sn, &cs);
          zs[t * 33 + 1 + b] = cs; zs[t * 33 + 17 + b] = -sn;
          if (b == 0) zs[t * 33] = (float)tg / (float)(SEQ - 1); }
        __syncthreads();
        { const int t = tid & 31, u0 = (tid >> 5) * 4;
          f32x4 a = *(const LAS f32x4*)(B1s + u0);
#pragma unroll 11
          for (int f = 0; f < 33; ++f) { const float z = zs[t * 33 + f]; a += *(const LAS f32x4*)(W1s + f * 64 + u0) * z; }
          const f32x4 fr = *(const LAS f32x4*)(FRs + u0);
#pragma unroll
          for (int i = 0; i < 4; ++i) ha[t * 65 + u0 + i] = sinf(fr[i] * a[i]); }
        __syncthreads();
        { const int t = tid & 31, u0 = (tid >> 5) * 4;
          f32x4 a = *(const LAS f32x4*)(B2s + u0);
#pragma unroll 16
          for (int j = 0; j < 64; ++j) { const float z = ha[t * 65 + j]; a += *(const LAS f32x4*)(W2s + j * 64 + u0) * z; }
          const f32x4 fr = *(const LAS f32x4*)(FRs + u0);
#pragma unroll
          for (int i = 0; i < 4; ++i) hb[t * 65 + u0 + i] = sinf(fr[i] * a[i]); }
        __syncthreads();
        { const int t = tid & 31, u0 = (tid >> 5) * 4;
          f32x4 a = *(const LAS f32x4*)(B3s + u0);
#pragma unroll 16
          for (int j = 0; j < 64; ++j) { const float z = hb[t * 65 + j]; a += *(const LAS f32x4*)(W3s + j * 64 + u0) * z; }
          const f32x4 fr = *(const LAS f32x4*)(FRs + u0);
#pragma unroll
          for (int i = 0; i < 4; ++i) h3[t * 68 + u0 + i] = sinf(fr[i] * a[i]); }
        __syncthreads();
        { const int r32 = lane & 31, hi = lane >> 5;
          bf16x8 bh[4], bl[4];
#pragma unroll
          for (int ks = 0; ks < 4; ++ks) { const LAS float* hp = h3 + r32 * 68 + 16 * ks + 8 * hi; const f32x4 x0 = *(const LAS f32x4*)hp, x1 = *(const LAS f32x4*)(hp + 4);
              u32x4 wh, wl;
#pragma unroll
              for (int q = 0; q < 2; ++q) { const f32x4 x = q ? x1 : x0;
                  const unsigned h01 = cvt_pk_bf16(x[0], x[1]), h23 = cvt_pk_bf16(x[2], x[3]);
                  wh[2 * q] = h01; wh[2 * q + 1] = h23;
                  wl[2 * q] = cvt_pk_bf16(x[0] - bf_lo(h01), x[1] - bf_hi(h01)); wl[2 * q + 1] = cvt_pk_bf16(x[2] - bf_lo(h23), x[3] - bf_hi(h23)); }
              bh[ks] = *reinterpret_cast<bf16x8*>(&wh); bl[ks] = *reinterpret_cast<bf16x8*>(&wl); }
          const int tg = t0 + r32; const float tn = (float)tg / (float)(SEQ - 1);
#define F4_LOAD(A, ob_) do { const float* wp_ = w4 + (size_t)(8 * hi) * 2048 + 256 * wave + 32 * (ob_) + r32; \
              _Pragma("unroll") for (int ks = 0; ks < 4; ++ks) _Pragma("unroll") for (int i = 0; i < 8; ++i) A[ks][i] = wp_[(size_t)(16 * ks + i) * 2048]; } while (0)
#define F4_PROC(A, ob_) do { const int o0 = 256 * wave + 32 * (ob_); \
              float dcy[16]; _Pragma("unroll") for (int r = 0; r < 16; ++r) dcy[r] = decay[o0 + (r & 3) + 8 * (r >> 2) + 4 * hi]; \
              f32x16 acc = {}; \
              _Pragma("unroll") for (int ks = 0; ks < 4; ++ks) { u32x4 wh, wl; \
                  _Pragma("unroll") for (int q = 0; q < 4; ++q) { const float x0 = A[ks][2 * q], x1 = A[ks][2 * q + 1]; const unsigned h = cvt_pk_bf16(x0, x1); \
                      wh[q] = h; wl[q] = cvt_pk_bf16(x0 - bf_lo(h), x1 - bf_hi(h)); } \
                  const bf16x8 ah = *reinterpret_cast<bf16x8*>(&wh), al = *reinterpret_cast<bf16x8*>(&wl); \
                  acc = __builtin_amdgcn_mfma_f32_32x32x16_bf16(ah, bh[ks], acc, 0, 0, 0); \
                  acc = __builtin_amdgcn_mfma_f32_32x32x16_bf16(ah, bl[ks], acc, 0, 0, 0); \
                  acc = __builtin_amdgcn_mfma_f32_32x32x16_bf16(al, bh[ks], acc, 0, 0, 0); } \
              _Pragma("unroll") for (int r = 0; r < 16; ++r) { const int o = o0 + (r & 3) + 8 * (r >> 2) + 4 * hi; \
                  const float v = acc[r] * __expf(-tn * fabsf(dcy[r])); \
                  hf[(size_t)o * SEQ + tg] = v; \
                  float av = (o >= HYW && tg == 0) ? 0.f : fabsf(v); \
                  _Pragma("unroll") for (int m = 1; m < 32; m <<= 1) av += __shfl_xor(av, m); \
                  if (r32 == 0) psum[(size_t)o * 256 + tile] = av; } } while (0)
          float wa[4][8], wb[4][8];
          F4_LOAD(wa, 0);
          _Pragma("nounroll") for (int ob = 0; ob < 8; ob += 2) {
              F4_LOAD(wb, ob + 1);
              F4_PROC(wa, ob);
              if (ob + 2 < 8) F4_LOAD(wa, ob + 2);
              F4_PROC(wb, ob + 1);
          }
#undef F4_LOAD
#undef F4_PROC
        }
    }
    __syncthreads();
}

template <bool CTXPART>
__device__ __forceinline__ void phase_norm(const Params& p, const float* src_lat, const float* src_ctx, int nrows, const float* g, int chunk_shift, bf16_t* dst, int bid, int nb, int wv) {
    const int tid = TIDX(wv), wave = tid >> 6, lane = tid & 63;
    const float* mod = (const float*)(p.ws + WS_MOD);
#define NR_LOAD(V, r_) do { const float* xr_ = ((r_) < MLAT) ? (src_lat + (size_t)(r_) * DM) : (src_ctx + (size_t)((r_) - MLAT) * DM); \
        _Pragma("unroll") for (int j = 0; j < 8; ++j) V[j] = *(const f32x4*)(xr_ + 4 * (64 * j + lane)); } while (0)
#define NR_MAP(q_) (((nb == 256) && (q_) < MLAT) ? (2048 * ((((q_) & 2047) >> 3) & 7) + ((((q_) & 2047) >> 6) * 8 + ((q_) & 7)) + 256 * ((q_) >> 11)) : (q_))
    f32x4 vn[8];
    f32x4 gam[8], bet[8]; int cur_mi = -1;
    { const int q0 = bid * 8 + wave; if (q0 < nrows) { const int r0 = NR_MAP(q0); NR_LOAD(vn, r0); } }
    for (int q = bid * 8 + wave; q < nrows; q += nb * 8) {
        const int r = NR_MAP(q);
        const int mi = r < SEQ ? 0 : (r < MLAT ? 1 : 2);
        if (mi != cur_mi) { cur_mi = mi;
            const float* sh = mod + (size_t)mi * NMODC + (size_t)chunk_shift * DM; const float* sc = sh + DM;
#pragma unroll
            for (int j = 0; j < 8; ++j) { const int k = 4 * (64 * j + lane); gam[j] = *(const f32x4*)(g + k) * (*(const f32x4*)(sc + k) + 1.0f); bet[j] = *(const f32x4*)(sh + k); } }
        f32x4 v[8]; float ss = 0.f;
#pragma unroll
        for (int j = 0; j < 8; ++j) v[j] = vn[j];
        { const int qn = q + nb * 8; if (qn < nrows) { const int rn = NR_MAP(qn); NR_LOAD(vn, rn); } }
#pragma unroll
        for (int j = 0; j < 8; ++j) {
            if (CTXPART && r >= MLAT) {
                const float* pp = p.out + PART_OFF + (size_t)(r - MLAT) * DM + 4 * (64 * j + lane);
                f32x4 s4 = *(const f32x4*)pp;
#pragma unroll
                for (int q = 1; q < pg8::NSPLIT; ++q) s4 += *(const f32x4*)(pp + (size_t)q * MCTX * DM);
                const f32x4 g4 = *(const f32x4*)(mod + (size_t)2 * NMODC + 2 * DM + 4 * (64 * j + lane));
                v[j] = v[j] + 0.5f * g4 * s4; }
            ss += (v[j][0] * v[j][0] + v[j][1] * v[j][1]) + (v[j][2] * v[j][2] + v[j][3] * v[j][3]); }
        const float rstd = rsqrtf(wave_sum(ss) * (1.0f / DM) + EPSN);
        bf16_t* orow = dst + (size_t)r * DM;
#pragma unroll
        for (int j = 0; j < 8; ++j) { const int k = 4 * (64 * j + lane);
            const f32x4 h = (v[j] * rstd) * gam[j] + bet[j];
            u32x2 w; w.x = cvt_pk_bf16(h[0], h[1]); w.y = cvt_pk_bf16(h[2], h[3]);
            *(u32x2*)(orow + k) = w; }
    }
#undef NR_LOAD
#undef NR_MAP
}

__device__ __forceinline__ int PI(int a) { return a + (a >> 5); }
__device__ __forceinline__ f32x2 cmul(f32x2 a, f32x2 b) { const f32x2 axx = {a.x, a.x}, ayy = {a.y, a.y}, bs = {-b.y, b.x}; return axx * b + ayy * bs; }
template <bool INV> __device__ __forceinline__ f32x2 twid(float frac) { const float c = __builtin_amdgcn_cosf(frac), s = __builtin_amdgcn_sinf(frac); return (f32x2){c, INV ? s : -s}; }
template <bool INV> __device__ __forceinline__ f32x2 k16(int mp) {
    constexpr float c1 = 0.9238795325112867f, s1 = 0.3826834323650898f, c2 = 0.7071067811865476f;
    const float c = mp == 0 ? 1.f : (mp == 1 ? c1 : (mp == 2 ? c2 : s1)), s = mp == 0 ? 0.f : (mp == 1 ? s1 : (mp == 2 ? c2 : c1));
    return (f32x2){c, INV ? s : -s};
}
__device__ __forceinline__ void dif4n(f32x2& a0, f32x2& a1, f32x2& a2, f32x2& a3) {
    const f32x2 b0 = a0 + a2, b1 = a0 - a2, b2 = a1 + a3, d = a1 - a3; const f32x2 b3 = (f32x2){d.y, -d.x};
    a0 = b0 + b2; a1 = b1 + b3; a2 = b0 - b2; a3 = b1 - b3;
}
__device__ __forceinline__ void dif4w(f32x2& a0, f32x2& a1, f32x2& a2, f32x2& a3, f32x2 w1) {
    const f32x2 w2 = cmul(w1, w1), w3 = cmul(w2, w1);
    dif4n(a0, a1, a2, a3);
    a1 = cmul(a1, w1); a2 = cmul(a2, w2); a3 = cmul(a3, w3);
}
__device__ __forceinline__ void dit4n(f32x2& a0, f32x2& a1, f32x2& a2, f32x2& a3) {
    const f32x2 b0 = a0 + a2, b1 = a0 - a2, b2 = a1 + a3, d = a1 - a3; const f32x2 b3 = (f32x2){-d.y, d.x};
    a0 = b0 + b2; a1 = b1 + b3; a2 = b0 - b2; a3 = b1 - b3;
}
__device__ __forceinline__ void dit4w(f32x2& a0, f32x2& a1, f32x2& a2, f32x2& a3, f32x2 w1) {
    const f32x2 w2 = cmul(w1, w1), w3 = cmul(w2, w1);
    a1 = cmul(a1, w1); a2 = cmul(a2, w2); a3 = cmul(a3, w3);
    dit4n(a0, a1, a2, a3);
}
template <bool J0> __device__ __forceinline__ void r16_fwd(f32x2 (&e)[16], f32x2 w) {
#pragma unroll
    for (int mp = 0; mp < 4; ++mp) {
        if (J0 && mp == 0) dif4n(e[0], e[4], e[8], e[12]);
        else dif4w(e[mp], e[mp + 4], e[mp + 8], e[mp + 12], J0 ? k16<false>(mp) : (mp == 0 ? w : cmul(w, k16<false>(mp))));
    }
    f32x2 w4 = w; if (!J0) { w4 = cmul(w, w); w4 = cmul(w4, w4); }
#pragma unroll
    for (int k = 0; k < 4; ++k) { if (J0) dif4n(e[4 * k], e[4 * k + 1], e[4 * k + 2], e[4 * k + 3]); else dif4w(e[4 * k], e[4 * k + 1], e[4 * k + 2], e[4 * k + 3], w4); }
}
template <bool J0> __device__ __forceinline__ void r16_inv(f32x2 (&e)[16], f32x2 w) {
    f32x2 w4 = w; if (!J0) { w4 = cmul(w, w); w4 = cmul(w4, w4); }
#pragma unroll
    for (int k = 0; k < 4; ++k) { if (J0) dit4n(e[4 * k], e[4 * k + 1], e[4 * k + 2], e[4 * k + 3]); else dit4w(e[4 * k], e[4 * k + 1], e[4 * k + 2], e[4 * k + 3], w4); }
#pragma unroll
    for (int mp = 0; mp < 4; ++mp) {
        if (J0 && mp == 0) dit4n(e[0], e[4], e[8], e[12]);
        else dit4w(e[mp], e[mp + 4], e[mp + 8], e[mp + 12], J0 ? k16<true>(mp) : (mp == 0 ? w : cmul(w, k16<true>(mp))));
    }
}
template <bool INV> __device__ __forceinline__ void fft_passB(LAS f32x2* X, int wv) {
    const int tid = TIDX(wv);
    _Pragma("nounroll") for (int it = 0; it < 2; ++it) { const int u = tid + NTHR * it, blk = u >> 6, j = u & 63; const int a0 = PI(blk * 1024 + j);
        f32x2 e[16];
#pragma unroll
        for (int m = 0; m < 16; ++m) e[m] = X[a0 + 66 * m];
        const f32x2 w = twid<INV>((float)j * (1.0f / 1024.0f));
        if (!INV) r16_fwd<false>(e, w); else r16_inv<false>(e, w);
#pragma unroll
        for (int m = 0; m < 16; ++m) X[a0 + 66 * m] = e[m]; }
}
template <bool INV> __device__ __forceinline__ void fft_passC(LAS f32x2* X, int wv) {
    const int tid = TIDX(wv);
    _Pragma("nounroll") for (int it = 0; it < 8; ++it) { const int u = tid + NTHR * it, blk = u >> 4, j = u & 15; const int a = blk * 66 + j;
        f32x2 e0 = X[a], e1 = X[a + 16], e2 = X[a + 33], e3 = X[a + 49];
        const f32x2 w = twid<INV>((float)j * (1.0f / 64.0f));
        if (!INV) dif4w(e0, e1, e2, e3, w); else dit4w(e0, e1, e2, e3, w);
        X[a] = e0; X[a + 16] = e1; X[a + 33] = e2; X[a + 49] = e3; }
}

__device__ __forceinline__ int rev4_7(int x) {
    unsigned r = (unsigned)x;
    r = ((r & 0x3333u) << 2) | ((r >> 2) & 0x3333u);
    r = ((r & 0x0F0Fu) << 4) | ((r >> 4) & 0x0F0Fu);
    r = ((r & 0x00FFu) << 8) | ((r >> 8) & 0x00FFu);
    return (int)(r >> 2);
}
__device__ __forceinline__ void phase_filter_fft(const Params& p, LAS unsigned char* lds, int bid, int nb, int wv) {
    const int tid = TIDX(wv), lane = tid & 63, wave = tid >> 6;
    LAS f32x2* X = (LAS f32x2*)lds;
    LAS float* red = (LAS float*)(lds + 135168);
    const float* hf = (const float*)(p.ws + WS_HF); const float* psum = (const float*)(p.ws + WS_PSUM);
    unsigned* Kf = (unsigned*)p.out;
    for (int c = bid; c < HYW / 2; c += nb) {
        const int c2 = c + HYW / 2;
        __syncthreads();
        float a1 = 0.f, a2 = 0.f;
        if (tid < 256) { a1 = psum[(size_t)c * 256 + tid] + psum[(size_t)(HYW + c) * 256 + tid]; a2 = psum[(size_t)c2 * 256 + tid] + psum[(size_t)(HYW + c2) * 256 + tid]; }
        a1 = wave_sum(a1); a2 = wave_sum(a2);
        if (lane == 0) { red[wave] = a1; red[8 + wave] = a2; }
        __syncthreads();
        const float s1 = 1.0f / ((red[0] + red[1]) + (red[2] + red[3])), s2 = 1.0f / ((red[8] + red[9]) + (red[10] + red[11]));
        const float* kf1 = hf + (size_t)c * SEQ; const float* kb1 = hf + (size_t)(HYW + c) * SEQ;
        const float* kf2 = hf + (size_t)c2 * SEQ; const float* kb2 = hf + (size_t)(HYW + c2) * SEQ;
_Pragma("nounroll") for (int it = 0; it < 2; ++it) { const int j = tid + NTHR * it; const int a0 = PI(j);
            f32x2 e[16];
#pragma unroll
            for (int m = 0; m < 8; ++m) e[m] = (f32x2){kf1[j + 1024 * m] * s1, kf2[j + 1024 * m] * s2};
#pragma unroll
            for (int m = 8; m < 16; ++m) { const int n = j + 1024 * m; const int ix = (n == SEQ) ? 1 : (FFTN - n);
                e[m] = (n == SEQ) ? (f32x2){0.f, 0.f} : (f32x2){kb1[ix] * s1, kb2[ix] * s2}; }
            r16_fwd<false>(e, twid<false>((float)j * (1.0f / 16384.0f)));
#pragma unroll
            for (int m = 0; m < 16; ++m) X[a0 + 1056 * m] = e[m]; }
        __syncthreads();
        fft_passB<false>(X, wv);
        __syncthreads();
        fft_passC<false>(X, wv);
        __syncthreads();
        _Pragma("nounroll") for (int it = 0; it < 2; ++it) { const int u = tid + NTHR * it; const int a0 = 16 * u + (u >> 1);
            f32x2 e[16];
#pragma unroll
            for (int m = 0; m < 16; ++m) e[m] = X[a0 + m];
            r16_fwd<true>(e, (f32x2){1.f, 0.f});
#pragma unroll
            for (int m = 0; m < 16; ++m) X[a0 + m] = e[m] * (0.5f / (float)FFTN); }
        __syncthreads();
        unsigned* d1 = Kf + (size_t)c * FFTN; unsigned* d2 = Kf + (size_t)c2 * FFTN;
        _Pragma("nounroll") for (int it = 0; it < FFTN / NTHR; ++it) { const int q = tid + NTHR * it;
            const int k = rev4_7(q), q2 = rev4_7((FFTN - k) & (FFTN - 1));
            const f32x2 a = X[PI(q)], b = X[PI(q2)];
            d1[q] = cvt_pk_bf16(a.x + b.x, a.y - b.y);
            d2[q] = cvt_pk_bf16(a.y + b.y, b.x - a.x); }
    }
    __syncthreads();
}

__device__ __forceinline__ void phase_prep_qkv(const Params& p, int bid, int nb, int wv) {
    const int tid = TIDX(wv), wave = tid >> 6, lane = tid & 63;
    const bf16_t* P = (const bf16_t*)(p.ws + WS_P);
    bf16_t* Q = (bf16_t*)(p.ws + WS_Q); bf16_t* Kd = (bf16_t*)(p.ws + WS_K); bf16_t* Vd = (bf16_t*)(p.ws + WS_V);
    const float qn0 = p.in[12][2 * lane], qn1 = p.in[12][2 * lane + 1], kn0 = p.in[13][2 * lane], kn1 = p.in[13][2 * lane + 1];
    const float inv = exp2f(-(float)(2 * (lane & 31)) * (13.287712379549449f / 64.0f));
#define QK_LOAD(W, r_) do { const unsigned* pr_ = (const unsigned*)(P + (size_t)(r_) * INW); \
        _Pragma("unroll") for (int h = 0; h < 12; ++h) W[h] = pr_[h * 64 + lane]; } while (0)
    unsigned wn[12];
    { const int r0 = bid * 8 + wave; if (r0 < MTOT) QK_LOAD(wn, r0); }
    for (int r = bid * 8 + wave; r < MTOT; r += nb * 8) {
        unsigned prow[12];
#pragma unroll
        for (int h = 0; h < 12; ++h) prow[h] = wn[h];
        { const int rn = r + nb * 8; if (rn < MTOT) QK_LOAD(wn, rn); }
        const bool lat = r < MLAT;
        int b, t; float cs = 1.f, sn = 0.f;
        if (lat) { b = r / SEQ; t = r - b * SEQ; const int pos = (lane < 32) ? (t >> 6) : (t & 63); sincosf((float)pos * inv, &sn, &cs); }
        else { b = (r - MLAT) / CTXL; t = (r - MLAT) - b * CTXL; }
        const int kpos = lat ? (CTXL + t) : t;
        if (lat) {
#pragma unroll
            for (int h = 0; h < NQH; ++h) { const unsigned w = prow[h]; const float x0 = bf_lo(w), x1 = bf_hi(w);
                const float rs = rsqrtf(wave_sum(x0 * x0 + x1 * x1) * (1.0f / HD) + EPSN);
                const float y0 = x0 * rs * qn0, y1 = x1 * rs * qn1;
                *(unsigned*)(Q + ((size_t)(b * NQH + h) * SEQ + t) * HD + 2 * lane) = cvt_pk_bf16(y0 * cs - y1 * sn, y0 * sn + y1 * cs); }
        }
#pragma unroll
        for (int h = 0; h < NKVH; ++h) { const unsigned w = prow[8 + h]; const float x0 = bf_lo(w), x1 = bf_hi(w);
            const float rs = rsqrtf(wave_sum(x0 * x0 + x1 * x1) * (1.0f / HD) + EPSN);
            const float y0 = x0 * rs * kn0, y1 = x1 * rs * kn1;
            *(unsigned*)(Kd + ((size_t)(b * NKVH + h) * LKEYS + kpos) * HD + 2 * lane) = cvt_pk_bf16(y0 * cs - y1 * sn, y0 * sn + y1 * cs);
            *(unsigned*)(Vd + ((size_t)(b * NKVH + h) * LKEYS + kpos) * HD + 2 * lane) = prow[10 + h]; }
    }
}

__device__ __forceinline__ void phase_prep_hyena(const Params& p, LAS unsigned char* lds, int bid, int nb, int wv) {
    const int tid = TIDX(wv), wave = tid >> 6, lane = tid & 63;
    const bf16_t* P = (const bf16_t*)(p.ws + WS_P);
    bf16_t* vxT = (bf16_t*)(p.ws + WS_VXT); bf16_t* x0T = (bf16_t*)(p.ws + WS_X0T);
    const float* cw = p.in[14]; const float* cb = p.in[15];
    LAS float* vxs = (LAS float*)lds; LAS float* x0s = vxs + 128 * 65;
    constexpr int NCB = HYW / 128, NTB = NBATCH * (SEQ / 64);
    for (int w0i = bid; w0i < NCB * 32; w0i += nb) {
        const int cblk = w0i & (NCB - 1), strand = w0i >> 3;
        const int c2 = cblk * 128 + 2 * lane;
        float wt[3][2][4];
#pragma unroll
        for (int part = 0; part < 3; ++part)
#pragma unroll
            for (int ch = 0; ch < 2; ++ch) { const int col = part * HYW + c2 + ch; wt[part][ch][0] = cw[col]; wt[part][ch][1] = cw[3 * HYW + col]; wt[part][ch][2] = cw[6 * HYW + col]; wt[part][ch][3] = cb[col]; }
#define HY_LOAD(U, g_) do { const int b_ = (g_) >> 7, tw_ = ((g_) & 127) * 64 + wave * 8; _Pragma("unroll") for (int part = 0; part < 3; ++part) _Pragma("unroll") for (int i = 0; i < 10; ++i) { \
        const int tt = tw_ + i - 1; U[part][i] = (tt >= 0 && tt < SEQ) ? *(const unsigned*)(P + (size_t)(b_ * SEQ + tt) * INW + (ATW + 2 * NKVH * HD) + part * HYW + c2) : 0u; } } while (0)
#define HY_PROC(U, g_) do { const int b_ = (g_) >> 7, tb_ = (g_) & 127; float uc[3][8][2]; \
        _Pragma("unroll") for (int part = 0; part < 3; ++part) _Pragma("unroll") for (int i = 0; i < 8; ++i) { \
            uc[part][i][0] = bf_lo(U[part][i]) * wt[part][0][0] + bf_lo(U[part][i + 1]) * wt[part][0][1] + bf_lo(U[part][i + 2]) * wt[part][0][2] + wt[part][0][3]; \
            uc[part][i][1] = bf_hi(U[part][i]) * wt[part][1][0] + bf_hi(U[part][i + 1]) * wt[part][1][1] + bf_hi(U[part][i + 2]) * wt[part][1][2] + wt[part][1][3]; } \
        __syncthreads(); \
        _Pragma("unroll") for (int i = 0; i < 8; ++i) _Pragma("unroll") for (int ch = 0; ch < 2; ++ch) { \
            vxs[(2 * lane + ch) * 65 + wave * 8 + i] = uc[2][i][ch] * uc[1][i][ch]; x0s[(2 * lane + ch) * 65 + wave * 8 + i] = uc[0][i][ch]; } \
        __syncthreads(); \
        { const int cc = tid >> 2, seg = tid & 3; const LAS float* a = vxs + cc * 65 + seg * 16; const LAS float* d = x0s + cc * 65 + seg * 16; \
          const size_t o = (size_t)(cblk * 128 + cc) * MLAT + (size_t)b_ * SEQ + tb_ * 64 + seg * 16; \
          _Pragma("unroll") for (int h = 0; h < 2; ++h) { u32x4 wa, wd; \
              wa.x = cvt_pk_bf16(a[8 * h + 0], a[8 * h + 1]); wa.y = cvt_pk_bf16(a[8 * h + 2], a[8 * h + 3]); wa.z = cvt_pk_bf16(a[8 * h + 4], a[8 * h + 5]); wa.w = cvt_pk_bf16(a[8 * h + 6], a[8 * h + 7]); \
              wd.x = cvt_pk_bf16(d[8 * h + 0], d[8 * h + 1]); wd.y = cvt_pk_bf16(d[8 * h + 2], d[8 * h + 3]); wd.z = cvt_pk_bf16(d[8 * h + 4], d[8 * h + 5]); wd.w = cvt_pk_bf16(d[8 * h + 6], d[8 * h + 7]); \
              *(u32x4*)(vxT + o + 8 * h) = wa; *(u32x4*)(x0T + o + 8 * h) = wd; } } } while (0)
        unsigned UA[3][10], UB[3][10];
        HY_LOAD(UA, strand);
        _Pragma("nounroll") for (int g = strand; g < NTB; g += 64) {
            if (g + 32 < NTB) HY_LOAD(UB, g + 32);
            HY_PROC(UA, g);
            if (g + 32 < NTB) { if (g + 64 < NTB) HY_LOAD(UA, g + 64); HY_PROC(UB, g + 32); }
        }
#undef HY_LOAD
#undef HY_PROC
    }
    __syncthreads();
}

__device__ __forceinline__ void phase_attention(const Params& p, unsigned char* lds_g, int bid, int nb, int wv) {
    const bf16_t* Q = (const bf16_t*)(p.ws + WS_Q); const bf16_t* Kd = (const bf16_t*)(p.ws + WS_K); const bf16_t* Vd = (const bf16_t*)(p.ws + WS_V);
    float* O = (float*)(p.ws + WS_ATTN);
    constexpr int NU = NBATCH * NQH * (SEQ / 256);
    for (int u = bid; u < NU; u += nb) {
        const int b = u >> 8, w = u & 255, x = w & 7, i = w >> 3;
        const int kvh = x >> 2, qh = kvh * 4 + (x & 3), qblk = i;
        __syncthreads();
        att::attn_dense_body(Q + ((size_t)(b * NQH + qh) * SEQ + qblk * 256) * HD, Kd + (size_t)(b * NKVH + kvh) * LKEYS * HD, Vd + (size_t)(b * NKVH + kvh) * LKEYS * HD,
                             O + ((size_t)b * SEQ + qblk * 256) * ATW + qh * HD, LKEYS, (char*)lds_g, wv);
    }
    __syncthreads();
}

__device__ __forceinline__ void phase_hyena_conv(const Params& p, LAS unsigned char* lds, int bid, int nb, int wv) {
    const int tid = TIDX(wv);
    LAS f32x2* X = (LAS f32x2*)lds;
    const bf16_t* vxT = (const bf16_t*)(p.ws + WS_VXT); const bf16_t* x0T = (const bf16_t*)(p.ws + WS_X0T);
    bf16_t* hyoT = (bf16_t*)(p.ws + WS_HYOT);
    const unsigned* Kf = (const unsigned*)p.out;
#define CV_LOADX(XR, c_) do { const bf16_t* a_ = vxT + (size_t)(c_) * MLAT + tid; const bf16_t* b_ = a_ + SEQ; \
        _Pragma("unroll") for (int it = 0; it < 2; ++it) _Pragma("unroll") for (int m = 0; m < 8; ++m) XR[it][m] = (unsigned)a_[NTHR * it + 1024 * m] | ((unsigned)b_[NTHR * it + 1024 * m] << 16); } while (0)
    unsigned xnext[2][8];
    if (bid < HYW) CV_LOADX(xnext, bid);
    for (int c = bid; c < HYW; c += nb) {
        __syncthreads();
        const unsigned* kf = Kf + (size_t)c * FFTN;
        unsigned xcur[2][8];
#pragma unroll
        for (int it = 0; it < 2; ++it)
#pragma unroll
            for (int m = 0; m < 8; ++m) xcur[it][m] = xnext[it][m];
        u32x4 kq[2][4];
#pragma unroll
        for (int it = 0; it < 2; ++it)
#pragma unroll
            for (int m = 0; m < 4; ++m) kq[it][m] = *(const u32x4*)(kf + 16 * (tid + NTHR * it) + 4 * m);
        _Pragma("nounroll") for (int it = 0; it < 2; ++it) { const int j = tid + NTHR * it; const int a0 = PI(j);
            f32x2 e[16];
            const f32x2 w = twid<false>((float)j * (1.0f / 16384.0f));
#pragma unroll
            for (int mp = 0; mp < 4; ++mp) { const unsigned r0 = it ? xcur[1][mp] : xcur[0][mp], r1 = it ? xcur[1][mp + 4] : xcur[0][mp + 4];
                const f32x2 x0 = (f32x2){bf_lo(r0), bf_hi(r0)}, x1 = (f32x2){bf_lo(r1), bf_hi(r1)};
                const f32x2 r = (f32x2){x1.y, -x1.x};
                const f32x2 w1 = (mp == 0) ? w : cmul(w, k16<false>(mp)), w2 = cmul(w1, w1), w3 = cmul(w2, w1);
                e[mp] = x0 + x1; e[mp + 4] = cmul(x0 + r, w1); e[mp + 8] = cmul(x0 - x1, w2); e[mp + 12] = cmul(x0 - r, w3); }
            f32x2 w4 = cmul(w, w); w4 = cmul(w4, w4);
#pragma unroll
            for (int k = 0; k < 4; ++k) dif4w(e[4 * k], e[4 * k + 1], e[4 * k + 2], e[4 * k + 3], w4);
#pragma unroll
            for (int m = 0; m < 16; ++m) X[a0 + 1056 * m] = e[m]; }
        __syncthreads();
        fft_passB<false>(X, wv);
        __syncthreads();
        fft_passC<false>(X, wv);
        __syncthreads();
        _Pragma("nounroll") for (int it = 0; it < 2; ++it) { const int u = tid + NTHR * it; const int a0 = 16 * u + (u >> 1);
            f32x2 e[16];
#pragma unroll
            for (int m = 0; m < 16; ++m) e[m] = X[a0 + m];
            r16_fwd<true>(e, (f32x2){1.f, 0.f});
#pragma unroll
            for (int m = 0; m < 16; ++m) { const unsigned kw = it ? kq[1][m >> 2][m & 3] : kq[0][m >> 2][m & 3]; e[m] = cmul(e[m], (f32x2){bf_lo(kw), bf_hi(kw)}); }
            r16_inv<true>(e, (f32x2){1.f, 0.f});
#pragma unroll
            for (int m = 0; m < 16; ++m) X[a0 + m] = e[m]; }
        if (c + nb < HYW) CV_LOADX(xnext, c + nb);
        unsigned egg[2][8];
        { const bf16_t* g0 = x0T + (size_t)c * MLAT + tid; const bf16_t* g1 = g0 + SEQ;
#pragma unroll
          for (int it = 0; it < 2; ++it)
#pragma unroll
              for (int m = 0; m < 8; ++m) egg[it][m] = (unsigned)g0[NTHR * it + 1024 * m] | ((unsigned)g1[NTHR * it + 1024 * m] << 16); }
        __syncthreads();
        fft_passC<true>(X, wv);
        __syncthreads();
        fft_passB<true>(X, wv);
        __syncthreads();
        const float hb = p.in[25][c];
        bf16_t* o0 = hyoT + (size_t)c * MLAT; bf16_t* o1 = o0 + SEQ;
        _Pragma("nounroll") for (int it = 0; it < 2; ++it) { const int j = tid + NTHR * it; const int a0 = PI(j);
            f32x2 e[16];
#pragma unroll
            for (int m = 0; m < 16; ++m) e[m] = X[a0 + 1056 * m];
            const f32x2 w = twid<true>((float)j * (1.0f / 16384.0f));
            f32x2 w4 = cmul(w, w); w4 = cmul(w4, w4);
#pragma unroll
            for (int k = 0; k < 4; ++k) dit4w(e[4 * k], e[4 * k + 1], e[4 * k + 2], e[4 * k + 3], w4);
#pragma unroll
            for (int mp = 0; mp < 4; ++mp) { const f32x2 w1 = (mp == 0) ? w : cmul(w, k16<true>(mp)), w2 = cmul(w1, w1), w3 = cmul(w2, w1);
                const f32x2 c0 = e[mp], c1 = cmul(e[mp + 4], w1), c2 = cmul(e[mp + 8], w2), c3 = cmul(e[mp + 12], w3);
                const f32x2 b0 = c0 + c2, b1 = c0 - c2, b2 = c1 + c3, d = c1 - c3; const f32x2 b3 = (f32x2){-d.y, d.x};
                const f32x2 y0 = b0 + b2, y1 = b1 + b3;
                const int t0 = j + 1024 * mp, t1 = t0 + 4096;
                const unsigned va = it ? xcur[1][mp] : xcur[0][mp], vb = it ? xcur[1][mp + 4] : xcur[0][mp + 4];
                const unsigned ga = it ? egg[1][mp] : egg[0][mp], gb = it ? egg[1][mp + 4] : egg[0][mp + 4];
                const unsigned ra = cvt_pk_bf16((y0.x + hb * bf_lo(va)) * bf_lo(ga), (y0.y + hb * bf_hi(va)) * bf_hi(ga)), rb = cvt_pk_bf16((y1.x + hb * bf_lo(vb)) * bf_lo(gb), (y1.y + hb * bf_hi(vb)) * bf_hi(gb));
                o0[t0] = (bf16_t)(ra & 0xffffu); o1[t0] = (bf16_t)(ra >> 16); o0[t1] = (bf16_t)(rb & 0xffffu); o1[t1] = (bf16_t)(rb >> 16); }
        }
    }
#undef CV_LOADX
    __syncthreads();
}

__device__ __forceinline__ void phase_merge(const Params& p, LAS unsigned char* lds, int bid, int nb, int wv) {
    const int tid = TIDX(wv), wave = tid >> 6, lane = tid & 63;
    const float* attn = (const float*)(p.ws + WS_ATTN); const bf16_t* hyoT = (const bf16_t*)(p.ws + WS_HYOT);
    bf16_t* Y = (bf16_t*)(p.ws + WS_HA);
    const float* gout = p.in[26];
    LAS float* ts = (LAS float*)lds;
    LAS float* part = ts + 128 * 65;
    LAS float* rh = part + 8 * 64;
#define MG_LOAD(V, ch_) do { const bf16_t* hp_ = hyoT + (size_t)((ch_) * 128 + wave * 16) * MLAT + tok0 + lane; _Pragma("unroll") for (int i = 0; i < 16; ++i) V[i] = hp_[(size_t)i * MLAT]; } while (0)
#define MG_PROC(V, ch_) do { const int c0_ = (ch_) * 128; const float rr_ = rh[lane]; \
        _Pragma("unroll") for (int i = 0; i < 16; ++i) ts[(wave * 16 + i) * 65 + lane] = bf2f(V[i]) * rr_ * gout[ATW + c0_ + wave * 16 + i]; \
        __syncthreads(); \
        _Pragma("unroll") for (int it = 0; it < 2; ++it) { const int item = tid + NTHR * it; const int tok = item >> 4, chunk = item & 15; \
            const LAS float* s = ts + (chunk * 8) * 65 + tok; \
            u32x4 w; w.x = cvt_pk_bf16(s[0], s[65]); w.y = cvt_pk_bf16(s[2 * 65], s[3 * 65]); w.z = cvt_pk_bf16(s[4 * 65], s[5 * 65]); w.w = cvt_pk_bf16(s[6 * 65], s[7 * 65]); \
            *(u32x4*)(Y + (size_t)(tok0 + tok) * DM + ATW + c0_ + chunk * 8) = w; } \
        __syncthreads(); } while (0)
    for (int tile = bid; tile < MLAT / 64; tile += nb) {
        const int tok0 = tile * 64;
        __syncthreads();
        { float ss = 0.f; const bf16_t* hp = hyoT + (size_t)(wave * 128) * MLAT + tok0 + lane;
#pragma unroll
          for (int cq = 0; cq < 2; ++cq) { bf16_t hv[64];
#pragma unroll
              for (int cc = 0; cc < 64; ++cc) hv[cc] = hp[(size_t)(cq * 64 + cc) * MLAT];
#pragma unroll
              for (int cc = 0; cc < 64; ++cc) { const float v = bf2f(hv[cc]); ss += v * v; } }
          part[wave * 64 + lane] = ss; }
#pragma unroll
        for (int half = 0; half < 2; ++half) {
            f32x4 v[4][4];
#pragma unroll
            for (int i = 0; i < 4; ++i) { const float* ar = attn + (size_t)(tok0 + wave * 8 + half * 4 + i) * ATW;
#pragma unroll
                for (int j = 0; j < 4; ++j) v[i][j] = *(const f32x4*)(ar + 4 * (64 * j + lane)); }
#pragma unroll
            for (int i = 0; i < 4; ++i) { const int tok = tok0 + wave * 8 + half * 4 + i; float ss = 0.f;
#pragma unroll
                for (int j = 0; j < 4; ++j) ss += (v[i][j][0] * v[i][j][0] + v[i][j][1] * v[i][j][1]) + (v[i][j][2] * v[i][j][2] + v[i][j][3] * v[i][j][3]);
                const float rs = rsqrtf(wave_sum(ss) * (1.0f / ATW) + EPSN);
#pragma unroll
                for (int j = 0; j < 4; ++j) { const int k = 4 * (64 * j + lane); const f32x4 gg = *(const f32x4*)(gout + k); const f32x4 h = v[i][j] * rs * gg;
                    u32x2 w; w.x = cvt_pk_bf16(h[0], h[1]); w.y = cvt_pk_bf16(h[2], h[3]); *(u32x2*)(Y + (size_t)tok * DM + k) = w; } }
        }
        __syncthreads();
        if (tid < 64) { float s = 0.f; for (int w = 0; w < 8; ++w) s += part[w * 64 + tid]; rh[tid] = rsqrtf(s * (1.0f / HYW) + EPSN); }
        __syncthreads();
        bf16_t va[16], vb[16];
        MG_LOAD(va, 0);
        _Pragma("nounroll") for (int ch = 0; ch < 8; ch += 2) {
            MG_LOAD(vb, ch + 1);
            MG_PROC(va, ch);
            if (ch + 2 < 8) MG_LOAD(va, ch + 2);
            MG_PROC(vb, ch + 1);
        }
    }
#undef MG_LOAD
#undef MG_PROC
    __syncthreads();
}

constexpr size_t WS_BAR = 512 * 1024;
constexpr int LDS_BARST = LDS_BYTES - 64;
#define XB_TMO      128
#define XB_XCNT(j)  (256  + 64 * (j))
#define XB_XSUB(j)  (1280 + 64 * (j))
#define XB_XGEN(j)  (2304 + 64 * (j))
#define XB_TOP      3328
#define XB_TOPGEN   3392
#define XCD_BAR_WORDS 3456
#define XB_SPIN_CAP (1u << 18)
__device__ __forceinline__ unsigned xb_ld(unsigned* p)              { return __hip_atomic_load(p, __ATOMIC_RELAXED, __HIP_MEMORY_SCOPE_AGENT); }
__device__ __forceinline__ unsigned xb_add(unsigned* p, unsigned v) { return __hip_atomic_fetch_add(p, v, __ATOMIC_RELAXED, __HIP_MEMORY_SCOPE_AGENT); }
__device__ __forceinline__ unsigned xb_xcc_id() { return (unsigned)__builtin_amdgcn_s_getreg((3 << 11) | 20) & 0xFu; }
#define XB_SPIN(cond, bar) do { unsigned _sp = 0; while (cond) { __builtin_amdgcn_s_sleep(1); \
    if ((++_sp & 255u) == 0u) { if (xb_ld(&(bar)[XB_TMO])) break; if (_sp > XB_SPIN_CAP) { atomicAdd(&(bar)[XB_TMO], 1u); break; } } } } while (0)
struct XcdBarrier { unsigned* bar; unsigned x; volatile LAS unsigned* st; };
__device__ __forceinline__ XcdBarrier xcd_barrier_post(unsigned* bar, volatile LAS unsigned* st, int tid) {
    XcdBarrier b; b.bar = bar; b.x = xb_xcc_id(); b.st = st;
    if (tid == 0) (void)xb_add(&bar[XB_XCNT(b.x)], 1u);
    return b;
}
__device__ __forceinline__ void xcd_barrier_complete(unsigned* bar, unsigned x, unsigned& nloc, unsigned& nx) {
    const unsigned G = gridDim.x * gridDim.y * gridDim.z;
    unsigned sum, cnt, mine, sp = 0u;
    for (;;) {
        sum = 0u; cnt = 0u; mine = 0u;
#pragma unroll
        for (unsigned j = 0; j < 16; ++j) { const unsigned c = xb_ld(&bar[XB_XCNT(j)]); sum += c; cnt += (c > 0u) ? 1u : 0u; mine = (j == x) ? c : mine; }
        if (sum == G) break;
        __builtin_amdgcn_s_sleep(1);
        if ((++sp & 255u) == 0u) { if (xb_ld(&bar[XB_TMO])) break; if (sp > XB_SPIN_CAP) { atomicAdd(&bar[XB_TMO], 1u); break; } }
    }
    nloc = mine > 0u ? mine : 1u; nx = cnt > 0u ? cnt : 1u;
}
__device__ __forceinline__ void xcd_barrier(const XcdBarrier& b, int wv) {
    asm volatile("s_waitcnt vmcnt(0)" ::: "memory");
    __syncthreads();
    if (TIDX(wv) == 0) {
        unsigned* bar = b.bar;
        __builtin_amdgcn_s_waitcnt(0);
        unsigned nloc = b.st[0], nx = b.st[1];
        if (nloc == 0u) { xcd_barrier_complete(bar, b.x, nloc, nx); b.st[0] = nloc; b.st[1] = nx; }
        const unsigned old = xb_add(&bar[XB_XSUB(b.x)], 1u);
        const unsigned gen = old / nloc;
        if (old + 1u == (gen + 1u) * nloc) {
            __builtin_amdgcn_fence(__ATOMIC_RELEASE, "agent");
            asm volatile("s_waitcnt vmcnt(0)" ::: "memory");
            const unsigned og = xb_add(&bar[XB_TOP], 1u);
            const unsigned tg = og / nx;
            if (og + 1u == (tg + 1u) * nx) xb_add(&bar[XB_TOPGEN], 1u);
            else XB_SPIN(xb_ld(&bar[XB_TOPGEN]) == tg, bar);
            __builtin_amdgcn_fence(__ATOMIC_ACQUIRE, "agent");
            xb_add(&bar[XB_XGEN(b.x)], 1u);
            asm volatile("s_waitcnt vmcnt(0)" ::: "memory");
        } else {
            XB_SPIN(xb_ld(&bar[XB_XGEN(b.x)]) == gen, bar);
            __builtin_amdgcn_fence(__ATOMIC_ACQUIRE, "agent");
            asm volatile("s_waitcnt vmcnt(0)" ::: "memory");
        }
    }
    __syncthreads();
}

constexpr int TR_SPLIT = (DM / 64) * (2 * DFF / 64) + (DFF / 64) * (DM / 64) + (DM / 64) * (INW / 64);
constexpr int TR_ALL = TR_SPLIT + (DM / 64) * (DM / 64) + (DM / 64) * (2 * DFF / 64) + (DFF / 64) * (DM / 64);
constexpr int NPHASE = 13;
__global__ void __launch_bounds__(NTHR, 2) mk_fwd(Params p) {
    extern __shared__ __attribute__((aligned(16))) unsigned char lds_g[];
    LAS unsigned char* lds = (LAS unsigned char*)lds_g;
    const int bid = blockIdx.x, nb = gridDim.x;
    const int wv = __builtin_amdgcn_readfirstlane(threadIdx.x >> 6);
    const int lo = p.ph_lo, hi = p.ph_hi;
    unsigned char* ws = p.ws;
    float* modp = (float*)(ws + WS_MOD);
    bf16_t* HA = (bf16_t*)(ws + WS_HA); bf16_t* ACT = (bf16_t*)(ws + WS_ACT); float* X1 = (float*)(ws + WS_X1);
#define IN(k) (lo <= (k) && (k) < hi)
#define VB(k) ((((p.dup_mask >> (k)) & 1) ? (bid >> 1) : bid))
#define VN(k) ((((p.dup_mask >> (k)) & 1) ? (nb >> 1) : nb))
#define VB2(k, j) ((((p.dup_mask >> (k)) | (p.dup_mask >> (j))) & 1) ? (bid >> 1) : bid)
#define VN2(k, j) ((((p.dup_mask >> (k)) | (p.dup_mask >> (j))) & 1) ? (nb >> 1) : nb)
#define SEAM(k) do { if (IN(k) && IN((k) + 1)) { xcd_barrier(bar, wv); } } while (0)
    if (p.ph_lo < 0) cg::this_grid().sync();
    XcdBarrier bar; bar.bar = (unsigned*)(ws + WS_BAR); bar.x = 0; bar.st = (volatile LAS unsigned*)(lds + LDS_BARST);
    if (hi - lo > 1) { if (TIDX(wv) == 0) { bar.st[0] = 0u; bar.st[1] = 0u; } __syncthreads(); bar = xcd_barrier_post((unsigned*)(ws + WS_BAR), (volatile LAS unsigned*)(lds + LDS_BARST), TIDX(wv)); }
    if (IN(0)) { phase_transpose(p, lds, 0, TR_SPLIT, VB2(0, 16), VN2(0, 16), wv); phase_mod(p, lds, VB2(0, 17), VN2(0, 17), wv); phase_filter(p, lds, (VB2(0, 15) + VN2(0, 15) / 2) % VN2(0, 15), VN2(0, 15), wv); }
    SEAM(0);
    if (IN(1)) { phase_norm<false>(p, p.in[0], p.in[2], MTOT, p.in[6], 0, HA, VB(1), VN(1), wv); phase_filter_fft(p, lds, VB2(1, 14), VN2(1, 14), wv); }
    SEAM(1);
    if (IN(2)) { pg8::Gemm g{HA, (const bf16_t*)(ws + WS_W1U), MTOT, 2 * DFF, DM, DM}; pg8::StaticOrder S; S.init(MTOT, 2 * DFF, VN(2), VB(2));
        pg8::EpiSwiglu E{ACT, DFF}; pg8::gemm_phase(lds, g, S, E, wv);
        { const int rem = ((MTOT / 256) * (2 * DFF / 256)) % nb;
          if (rem == 0 || (p.dup_mask & 4)) phase_transpose(p, lds, TR_SPLIT, TR_ALL, bid, nb, wv); else if (bid >= rem) phase_transpose(p, lds, TR_SPLIT, TR_ALL, bid - rem, nb - rem, wv); } }
    SEAM(2);
    if (IN(3)) { { pg8::Gemm g{ACT, (const bf16_t*)(ws + WS_W1D), MLAT, DM, DFF, DFF}; pg8::StaticOrder S; S.init(MLAT, DM, VN(3), VB(3));
          pg8::EpiResid E{p.in[0], p.in[2], X1, modp + 2 * DM, 0.5f}; pg8::gemm_phase(lds, g, S, E, wv); }
        { pg8::Gemm g{ACT, (const bf16_t*)(ws + WS_W1D), MTOT, DM, pg8::KSPLIT, DFF}; pg8::SplitOrder S; S.init(VN(3), VB(3));
          pg8::EpiPartial E{p.out + PART_OFF}; pg8::gemm_phase(lds, g, S, E, wv); } }
    SEAM(3);
    if (IN(4)) { phase_norm<true>(p, X1, p.in[2], MTOT, p.in[6] + DM, 3, HA, VB(4), VN(4), wv); }
    SEAM(4);
    if (IN(5)) { pg8::Gemm g{HA, (const bf16_t*)(ws + WS_WIN), MTOT, INW, DM, DM}; pg8::StaticOrder S; S.init(MTOT, INW, VN(5), VB(5));
        pg8::EpiBf16 E{(bf16_t*)(ws + WS_P), INW}; pg8::gemm_phase(lds, g, S, E, wv); }
    SEAM(5);
    if (IN(6)) { phase_prep_qkv(p, VB(6), VN(6), wv); phase_prep_hyena(p, lds, VB2(6, 18), VN2(6, 18), wv); }
    SEAM(6);
    if (IN(7)) { phase_attention(p, lds_g, VB(7), VN(7), wv); phase_hyena_conv(p, lds, VB2(7, 13), VN2(7, 13), wv); }
    SEAM(7);
    if (IN(8)) { phase_merge(p, lds, VB(8), VN(8), wv); }
    SEAM(8);
    if (IN(9)) { pg8::Gemm g{HA, (const bf16_t*)(ws + WS_WOUT), MLAT, DM, DM, DM}; pg8::StaticOrder S; S.init(MLAT, DM, VN(9), VB(9));
        pg8::EpiResid E{X1, X1, X1, modp + 5 * DM, 1.0f}; pg8::gemm_phase(lds, g, S, E, wv); }
    SEAM(9);
    if (IN(10)) { phase_norm<false>(p, X1, X1, MLAT, p.in[6] + 2 * DM, 6, HA, VB(10), VN(10), wv); }
    SEAM(10);
    if (IN(11)) { pg8::Gemm g{HA, (const bf16_t*)(ws + WS_W2U), MLAT, 2 * DFF, DM, DM}; pg8::StaticOrder S; S.init(MLAT, 2 * DFF, VN(11), VB(11));
        pg8::EpiSwiglu E{ACT, DFF}; pg8::gemm_phase(lds, g, S, E, wv); }
    SEAM(11);
    if (IN(12)) { pg8::Gemm g{ACT, (const bf16_t*)(ws + WS_W2D), MLAT, DM, DFF, DFF}; pg8::StaticOrder S; S.init(MLAT, DM, VN(12), VB(12));
        pg8::EpiResid E{X1, X1, p.out, modp + 8 * DM, 0.5f}; pg8::gemm_phase(lds, g, S, E, wv); }
#undef IN
#undef SEAM
}

extern "C" void kernel_launch(void* const* d_in, const int* in_sizes, int n_in, void* d_out, int out_size, void* d_ws, size_t ws_size, hipStream_t stream) {
    static int grid = 0;
    if (grid == 0) {
        if (n_in != 28 || out_size != MLAT * DM || ws_size < WS_END) { fprintf(stderr, "kernel_launch: unexpected shapes (n_in %d out %d ws %zu)\n", n_in, out_size, ws_size); grid = -1; return; }
        int dev = 0, cus = 0, per_cu = 0;
        hipGetDevice(&dev); hipDeviceGetAttribute(&cus, hipDeviceAttributeMultiprocessorCount, dev);
        if (hipFuncSetAttribute((const void*)mk_fwd, hipFuncAttributeMaxDynamicSharedMemorySize, LDS_BYTES) != hipSuccess) { fprintf(stderr, "kernel_launch: hipFuncSetAttribute failed\n"); grid = -1; return; }
        if (hipOccupancyMaxActiveBlocksPerMultiprocessor(&per_cu, (const void*)mk_fwd, NTHR, LDS_BYTES) != hipSuccess || per_cu < 1) { fprintf(stderr, "kernel_launch: occupancy query says %d\n", per_cu); per_cu = 1; }
        (void)hipGetLastError();
        grid = cus * 1;
    }
    if (grid < 0) return;
    Params p{};
    for (int i = 0; i < 28; ++i) p.in[i] = (const float*)d_in[i];
    p.out = (float*)d_out; p.ws = (unsigned char*)d_ws; p.dup_mask = DUP_MASK;
#if ONE_LAUNCH
    p.ph_lo = 0; p.ph_hi = NPHASE;
    void* args[] = {&p};
    if (hipMemsetAsync((char*)d_ws + WS_BAR, 0, XCD_BAR_WORDS * 4, stream) != hipSuccess) { fprintf(stderr, "kernel_launch: hipMemsetAsync of the barrier words failed\n"); return; }
    hipError_t e = hipLaunchCooperativeKernel((const void*)mk_fwd, dim3(grid), dim3(NTHR), args, LDS_BYTES, stream);
    if (e != hipSuccess) fprintf(stderr, "cooperative launch failed: %s (grid %d)\n", hipGetErrorString(e), grid);
#else
    for (int ph = 0; ph < NPHASE; ++ph) { p.ph_lo = ph; p.ph_hi = ph + 1;
        hipLaunchKernelGGL(mk_fwd, dim3(grid), dim3(NTHR), LDS_BYTES, stream, p); }
#endif
}
```
